# Optimizing an MI355X kernel written in HIP

```python
import math
import jax, jax.numpy as jnp
from jax import lax
import numpy as np

D_MODEL = 1024
BATCH = 8
SEQ = 4096
DEPTH = 2

N_BRANCH = 4
BR_WIDTH = D_MODEL // N_BRANCH
HEAD_DIM = 64
N_HEADS = BR_WIDTH // HEAD_DIM
CHUNK = 128
Q_BLOCK = 128
SHORT_CONV = 3
CONF_CONV = 31
EPS = 1e-6

SPLIT_SIZES = (
    2 * BR_WIDTH,
    BR_WIDTH,
    3 * BR_WIDTH,
    N_HEADS,
    BR_WIDTH,
    3 * BR_WIDTH,
    BR_WIDTH,
    2 * BR_WIDTH,
    BR_WIDTH,
    N_BRANCH * D_MODEL,
)
IN_COLS = sum(SPLIT_SIZES)
SPLIT_POINTS = tuple(int(v) for v in np.cumsum(SPLIT_SIZES)[:-1])

kernel_name = "hybrid_gated_parallel_mixers"


def rmsnorm(x, g):
    x32 = x.astype(jnp.float32)
    y = x32 * lax.rsqrt(jnp.mean(x32 * x32, axis=-1, keepdims=True) + EPS)
    return y.astype(x.dtype) * g


def layernorm(x, g, b):
    x32 = x.astype(jnp.float32)
    mu = jnp.mean(x32, axis=-1, keepdims=True)
    xc = x32 - mu
    var = jnp.mean(xc * xc, axis=-1, keepdims=True)
    return (xc * lax.rsqrt(var + EPS)).astype(x.dtype) * g + b


def causal_depthwise_conv(x, w):
    k_width, ch = w.shape
    return lax.conv_general_dilated(
        x, w.astype(x.dtype)[:, None, :],
        window_strides=(1,), padding=[(k_width - 1, 0)],
        dimension_numbers=("NWC", "WIO", "NWC"),
        feature_group_count=ch)


def gmlp_chunk_mixer(uv, sgu_w, sgu_b, ln_g, ln_b):
    bsz, seq, _ = uv.shape
    u, v = jnp.split(jax.nn.gelu(uv), 2, axis=-1)
    v = layernorm(v, ln_g, ln_b)
    n_chunks = seq // CHUNK
    vc = v.reshape(bsz, n_chunks, CHUNK, N_HEADS, HEAD_DIM)
    causal = jnp.tril(jnp.ones((CHUNK, CHUNK), dtype=bool))
    w = jnp.where(causal[None], sgu_w, jnp.zeros_like(sgu_w))
    mixed = jnp.einsum("hts,bnshd->bnthd", w, vc) + sgu_b.T[None, None, :, :, None]
    return u * mixed.reshape(bsz, seq, BR_WIDTH)


def forgetting_attention(qkv, f_logit, f_bias):
    bsz, seq, _ = qkv.shape
    q, k, v = jnp.split(qkv, 3, axis=-1)
    q = q.reshape(bsz, seq, N_HEADS, HEAD_DIM)
    k = k.reshape(bsz, seq, N_HEADS, HEAD_DIM)
    v = v.reshape(bsz, seq, N_HEADS, HEAD_DIM)
    log_f = jax.nn.log_sigmoid(f_logit.astype(jnp.float32) + f_bias.astype(jnp.float32))
    cum = jnp.cumsum(log_f, axis=1).transpose(0, 2, 1)
    n_blocks = seq // Q_BLOCK
    q_blocks = q.reshape(bsz, n_blocks, Q_BLOCK, N_HEADS, HEAD_DIM).transpose(1, 0, 2, 3, 4)
    c_blocks = cum.reshape(bsz, N_HEADS, n_blocks, Q_BLOCK).transpose(2, 0, 1, 3)
    key_pos = jnp.arange(seq)
    scale = 1.0 / math.sqrt(HEAD_DIM)
    neg = jnp.finfo(jnp.float32).min

    def one_block(args):
        qb, cb, idx = args
        s = jnp.einsum("bqhd,bkhd->bhqk", qb, k).astype(jnp.float32) * scale
        s = s + (cb[..., :, None] - cum[:, :, None, :])
        q_pos = idx * Q_BLOCK + jnp.arange(Q_BLOCK)
        mask = key_pos[None, :] <= q_pos[:, None]
        p = jax.nn.softmax(jnp.where(mask, s, neg), axis=-1).astype(v.dtype)
        return jnp.einsum("bhqk,bkhd->bqhd", p, v)

    out = lax.map(one_block, (q_blocks, c_blocks, jnp.arange(n_blocks)))
    return out.transpose(1, 0, 2, 3, 4).reshape(bsz, seq, BR_WIDTH)


def short_gated_conv(cin, conv_w):
    b_gate, c_gate, xin = jnp.split(cin, 3, axis=-1)
    return b_gate * causal_depthwise_conv(c_gate * xin, conv_w)


def conformer_conv(glu_in, dw_w, dw_b, ln_g, ln_b):
    a, g = jnp.split(glu_in, 2, axis=-1)
    h = a * jax.nn.sigmoid(g)
    h = causal_depthwise_conv(h, dw_w) + dw_b
    return jax.nn.silu(layernorm(h, ln_g, ln_b))


def setup_inputs(seed: int = 0) -> dict:
    key = jax.random.key(seed)
    ks = jax.random.split(key, 18)
    f32 = jnp.float32
    nrm = lambda k, shape, s: jax.random.normal(k, shape, f32) * s
    return {
        "x": jax.random.normal(ks[0], (BATCH, SEQ, D_MODEL), f32),
        "norm_g": 1.0 + nrm(ks[1], (DEPTH, D_MODEL), 0.02),
        "w_in": nrm(ks[2], (DEPTH, D_MODEL, IN_COLS), D_MODEL ** -0.5),
        "f_bias": jax.random.uniform(ks[3], (DEPTH, N_HEADS), f32, 1.0, 4.0),
        "sgu_w": nrm(ks[4], (DEPTH, N_HEADS, CHUNK, CHUNK), CHUNK ** -0.5),
        "sgu_b": 1.0 + nrm(ks[5], (DEPTH, N_HEADS, CHUNK), 0.02),
        "sgu_ln_g": 1.0 + nrm(ks[6], (DEPTH, BR_WIDTH), 0.02),
        "sgu_ln_b": nrm(ks[7], (DEPTH, BR_WIDTH), 0.02),
        "short_conv_w": nrm(ks[8], (DEPTH, SHORT_CONV, BR_WIDTH), SHORT_CONV ** -0.5),
        "conf_dw_w": nrm(ks[9], (DEPTH, CONF_CONV, BR_WIDTH), CONF_CONV ** -0.5),
        "conf_dw_b": nrm(ks[10], (DEPTH, BR_WIDTH), 0.02),
        "conf_ln_g": 1.0 + nrm(ks[11], (DEPTH, BR_WIDTH), 0.02),
        "conf_ln_b": nrm(ks[12], (DEPTH, BR_WIDTH), 0.02),
        "w_branch": nrm(ks[13], (DEPTH, N_BRANCH, BR_WIDTH, D_MODEL), BR_WIDTH ** -0.5),
        "w_out": nrm(ks[14], (DEPTH, D_MODEL, D_MODEL), D_MODEL ** -0.5),
        "final_g": 1.0 + nrm(ks[15], (D_MODEL,), 0.02),
    }


def reference(x, norm_g, w_in, f_bias, sgu_w, sgu_b, sgu_ln_g, sgu_ln_b,
              short_conv_w, conf_dw_w, conf_dw_b, conf_ln_g, conf_ln_b,
              w_branch, w_out, final_g):
    bsz, seq, _ = x.shape
    for layer in range(DEPTH):
        h = rmsnorm(x, norm_g[layer])
        proj = jnp.einsum("bsd,dc->bsc", h, w_in[layer])
        (a_uv, a_gate, b_qkv, b_f, b_gate, c_in, c_gate,
         d_glu, d_gate, merge_logits) = jnp.split(proj, SPLIT_POINTS, axis=-1)

        y_a = gmlp_chunk_mixer(a_uv, sgu_w[layer], sgu_b[layer],
                               sgu_ln_g[layer], sgu_ln_b[layer]) * jax.nn.silu(a_gate)
        y_b = forgetting_attention(b_qkv, b_f, f_bias[layer]) * jax.nn.silu(b_gate)
        y_c = short_gated_conv(c_in, short_conv_w[layer]) * jax.nn.silu(c_gate)
        y_d = conformer_conv(d_glu, conf_dw_w[layer], conf_dw_b[layer],
                             conf_ln_g[layer], conf_ln_b[layer]) * jax.nn.silu(d_gate)

        branches = jnp.stack([y_a, y_b, y_c, y_d], axis=2)
        projected = jnp.einsum("bsnc,ncd->bsnd", branches, w_branch[layer])
        gates = jax.nn.sigmoid(merge_logits.reshape(bsz, seq, N_BRANCH, D_MODEL))
        merged = jnp.sum(gates * projected, axis=2)
        x = x + jnp.einsum("bsd,de->bse", merged, w_out[layer])
    return rmsnorm(x, final_g)
```

```cpp
#include <hip/hip_runtime.h>
#include <hip/hip_cooperative_groups.h>
#include <cstdio>
#include <cstdint>
namespace cg = cooperative_groups;

#define LAS __attribute__((address_space(3)))
#define GAS __attribute__((address_space(1)))
typedef unsigned short bf16_t;
typedef short bf16x8 __attribute__((ext_vector_type(8)));
typedef short s16x4 __attribute__((ext_vector_type(4)));
typedef float f32x2 __attribute__((ext_vector_type(2)));
typedef float f32x4 __attribute__((ext_vector_type(4)));
typedef float f32x16 __attribute__((ext_vector_type(16)));
typedef unsigned u32x2 __attribute__((ext_vector_type(2)));
typedef unsigned u32x4 __attribute__((ext_vector_type(4)));
typedef __bf16 bf16x2_t __attribute__((ext_vector_type(2)));

constexpr int M = 32768, D = 1024, SEQ = 4096, NP = 3584, INC = 7684, NHEAD = 4;
constexpr float EPS = 1e-6f;
constexpr float LOG2E = 1.4426950408889634f;
constexpr float C2 = 0.125f * LOG2E;
constexpr int PC_U = 0, PC_V = 256, PC_AG = 512, PC_Q = 768, PC_K = 1024, PC_VV = 1280, PC_BG = 1536, PC_CB = 1792, PC_CC = 2048, PC_CX = 2304, PC_CG = 2560,
              PC_DA = 2816, PC_DS = 3072, PC_DG = 3328;
constexpr size_t MiB = 1u << 20;
constexpr size_t WS_STATS = 490 * MiB, WS_WF = 3 * MiB, WS_SGUW = 3 * MiB + 512 * 1024, WS_W1T = 4 * MiB, WS_WMT = 18 * MiB, WS_WBT = 34 * MiB, WS_WOT = 38 * MiB,
                 WS_XB = 42 * MiB, WS_R = 106 * MiB, WS_Y = 362 * MiB, WS_MRG = 426 * MiB, WS_END = 502 * MiB;
constexpr int SROW = 32;
constexpr size_t WS_CTL = 3 * MiB + 128 * 1024, CTL_BYTES = 16384;
constexpr int LDS_BYTES = 147456, MISC_OFF = 131072 + 320;

__device__ __forceinline__ unsigned pk_bf16(float lo, float hi) { f32x2 v = {lo, hi}; bf16x2_t b = __builtin_convertvector(v, bf16x2_t); return __builtin_bit_cast(unsigned, b); }
__device__ __forceinline__ float bf_lo(unsigned u) { return __uint_as_float(u << 16); }
__device__ __forceinline__ float bf_hi(unsigned u) { return __uint_as_float(u & 0xffff0000u); }
__device__ __forceinline__ void unpack8(const u32x4 v, float* f) {
  f[0] = bf_lo(v.x); f[1] = bf_hi(v.x); f[2] = bf_lo(v.y); f[3] = bf_hi(v.y); f[4] = bf_lo(v.z); f[5] = bf_hi(v.z); f[6] = bf_lo(v.w); f[7] = bf_hi(v.w);
}
__device__ __forceinline__ int opaque_v(int v) { asm volatile("" : "+v"(v)); return v; }
__device__ __forceinline__ float fast_sigmoid(float z) { return __builtin_amdgcn_rcpf(1.0f + __builtin_amdgcn_exp2f(-LOG2E * z)); }
__device__ __forceinline__ float act_apply(int act, float v) {
  if (act == 1) { const float u = 1.5957691216057308f * (v + 0.044715f * v * v * v); return v * fast_sigmoid(u); }
  if (act == 2) return v * fast_sigmoid(v);
  if (act == 3) return fast_sigmoid(v);
  if (act == 4) return v * C2;
  return v;
}

__device__ __forceinline__ float row_sumsq(const float* st_row) { return (st_row[0] + st_row[8]) + (st_row[16] + st_row[24]); }
__device__ __forceinline__ float row_rstd(const float* st_row) { return rsqrtf(row_sumsq(st_row) * (1.0f / D) + EPS); }

namespace pg8 {
#ifndef WGM_SEL
#define WGM_SEL 4
#endif
constexpr int BM = 256, BK = 64, HALF = 128, HTB = HALF * BK * 2, STAGE_BYTES = 8 * HTB, NXCD = 8, WGM = WGM_SEL;
__host__ __device__ __forceinline__ int lds_byte(int r, int c) { const int st = (r >> 4) * 2 + (c >> 5), rr = r & 15, cc = c & 31, ob = rr * 64 + cc * 2; return st * 1024 + (ob ^ (((ob >> 9) & 1) << 5)); }
__host__ __device__ __forceinline__ void stage_rc(int b, int& R, int& C) { const int st = b / 1024, sb = b % 1024, swz = sb ^ (((sb >> 9) & 1) << 5); R = (st >> 1) * 16 + swz / 64; C = (st & 1) * 32 + (swz % 64) / 2; }
__host__ __device__ __forceinline__ int perm32(int rho) { const int n = rho >> 4, i = rho & 15; return 8 * (i >> 2) + 4 * n + (i & 3); }

struct Unit { int pm, pn, z; size_t a_byte, b_byte; };
struct Gemm { const bf16_t* A; const bf16_t* Bt; int lda, ldb, K; };

struct SchedGrid {
  int nM, nN, nwg, G, c; size_t astep, bstep;
  __device__ void init(int Mr, int N, int G_, int c_, int lda, int ldb) { nM = Mr / BM; nN = N / BM; nwg = nM * nN; G = G_; c = c_; astep = (size_t)BM * lda * 2; bstep = (size_t)BM * ldb * 2; }
  __device__ bool next(int i, Unit& u) const {
    const long L = (long)i * G + c; if (L >= nwg) return false;
    int wgid = (int)L; { const int q = nwg / NXCD, r = nwg % NXCD, xcd = wgid % NXCD, off = wgid / NXCD; wgid = (xcd < r ? xcd * (q + 1) : r * (q + 1) + (xcd - r) * q) + off; }
    const int nig = WGM * nN, gid = wgid / nig, fm = gid * WGM, gsz = (nM - fm) < WGM ? (nM - fm) : WGM;
    u.pm = fm + ((wgid % nig) % gsz); u.pn = (wgid % nig) / gsz; u.z = 0; u.a_byte = (size_t)u.pm * astep; u.b_byte = (size_t)u.pn * bstep; return true;
  }
};
struct SchedPB {
  int vc;
  __device__ bool next(int i, Unit& u) const {
    if (i >= 8) return false; const int xq = vc & 7, jq = vc >> 3; const int pm = xq * 16 + (jq >> 1), pn = 2 * (jq & 1) + (i & 1), n = i >> 1;
    u.pm = pm; u.pn = pn; u.z = n; u.a_byte = ((size_t)pm * 256 * 1024 + (size_t)n * 256) * 2; u.b_byte = ((size_t)(n * 1024 + pn * 256) * 256) * 2; return true;
  }
};
struct SchedL {
  int vc;
  __device__ bool next(int i, Unit& u) const {
    if (i >= 8) return false; const int xq = vc & 7, jq = vc >> 3; const int pm = xq * 16 + (jq >> 1), pn = 8 * (jq & 1) + i;
    u.pm = pm; u.pn = pn; u.z = 0; u.a_byte = (size_t)pm * 256 * 1024 * 2; u.b_byte = (size_t)pn * 256 * 1024 * 2; return true;
  }
};

constexpr int RSTD_OFF = STAGE_BYTES + 6144;
struct RstdLds {
  const float* stats; LAS unsigned char* lds;
  __device__ __forceinline__ void request(const Unit* nx, int tid, float (&q)[4]) const {
    if (nx && tid < 256) { const GAS float* st = (const GAS float*)stats + (size_t)(nx->pm * BM + tid) * SROW; q[0] = st[0]; q[1] = st[8]; q[2] = st[16]; q[3] = st[24]; }
  }
  __device__ __forceinline__ void park(const Unit* nx, int par_next, int tid, const float (&q)[4]) const {
    if (nx && tid < 256) ((LAS float*)(lds + RSTD_OFF))[par_next * 256 + tid] = rsqrtf(((q[0] + q[1]) + (q[2] + q[3])) * (1.0f / D) + EPS);
  }
  __device__ __forceinline__ void prime(const Unit& u, int par, int tid) const {
    if (tid < 256) { const GAS float* st = (const GAS float*)stats + (size_t)(u.pm * BM + tid) * SROW; ((LAS float*)(lds + RSTD_OFF))[par * 256 + tid] = rsqrtf(((st[0] + st[8]) + (st[16] + st[24])) * (1.0f / D) + EPS); }
  }
  __device__ __forceinline__ float get(int par, int rl) const { return ((const LAS float*)(lds + RSTD_OFF))[par * 256 + rl]; }
};
struct Epi1 {
  static constexpr bool PERM = true;
  bf16_t* O; RstdLds R;
  __device__ __forceinline__ void pre(const Unit& u, int par, int tid) const { R.prime(u, par, tid); }
  __device__ __forceinline__ void operator()(const f32x4 (&acc)[2][2][4][2], const Unit& u, int wr, int wc, int fr, int fq, int par, bool has_nx, const Unit& nx) const {
    const int tid_ = (wr * 4 + wc) * 64 + fq * 16 + fr;
    const int pn = u.pn;
    const int act = (pn <= 1) ? 1 : (pn == 2 || pn == 6 || pn == 10 || pn == 13) ? 2 : (pn == 12) ? 3 : (pn == 3) ? 4 : 0;
    const int row0 = u.pm * BM + wr * 64 + fr; const int col0 = pn * BM + wc * 32 + 8 * fq;
#pragma unroll
    for (int ai = 0; ai < 2; ++ai)
#pragma unroll
      for (int m = 0; m < 4; ++m) {
        const int row = row0 + ai * HALF + m * 16;
        const float rs = R.get(par, ai * HALF + wr * 64 + m * 16 + fr);
        bf16_t* rowp = O + (size_t)row * NP + col0;
#pragma unroll
        for (int bj = 0; bj < 2; ++bj) {
          f32x4 v0 = acc[ai][bj][m][0] * rs, v1 = acc[ai][bj][m][1] * rs;
          if (act != 0) {
#pragma unroll
            for (int j = 0; j < 4; ++j) { v0[j] = act_apply(act, v0[j]); v1[j] = act_apply(act, v1[j]); }
          }
          u32x4 w; w.x = pk_bf16(v0[0], v0[1]); w.y = pk_bf16(v0[2], v0[3]); w.z = pk_bf16(v1[0], v1[1]); w.w = pk_bf16(v1[2], v1[3]);
          *(u32x4*)(rowp + bj * HALF) = w;
        }
      }
    if (has_nx) R.prime(nx, par ^ 1, tid_);
  }
};
struct Epi3a {
  static constexpr bool PERM = true;
  bf16_t* O;
  __device__ __forceinline__ void pre(const Unit&, int, int) const {}
  __device__ __forceinline__ void operator()(const f32x4 (&acc)[2][2][4][2], const Unit& u, int wr, int wc, int fr, int fq, int, bool, const Unit&) const {
    const int row0 = u.pm * BM + wr * 64 + fr; const int col0 = u.z * 1024 + u.pn * BM + wc * 32 + 8 * fq;
#pragma unroll
    for (int ai = 0; ai < 2; ++ai)
#pragma unroll
      for (int m = 0; m < 4; ++m) {
        bf16_t* rowp = O + (size_t)(row0 + ai * HALF + m * 16) * 4096 + col0;
#pragma unroll
        for (int bj = 0; bj < 2; ++bj) {
          const f32x4 v0 = acc[ai][bj][m][0], v1 = acc[ai][bj][m][1];
          u32x4 w; w.x = pk_bf16(v0[0], v0[1]); w.y = pk_bf16(v0[2], v0[3]); w.z = pk_bf16(v1[0], v1[1]); w.w = pk_bf16(v1[2], v1[3]);
          *(u32x4*)(rowp + bj * HALF) = w;
        }
      }
  }
};
struct Epi3b {
  static constexpr bool PERM = false;
  const bf16_t* P; bf16_t* O; RstdLds R;
  __device__ __forceinline__ void pre(const Unit& u, int par, int tid) const { R.prime(u, par, tid); }
  __device__ __forceinline__ void operator()(const f32x4 (&acc)[2][2][4][2], const Unit& u, int wr, int wc, int fr, int fq, int par, bool has_nx, const Unit& nx) const {
    const int tid_ = (wr * 4 + wc) * 64 + fq * 16 + fr;
    const int row0 = u.pm * BM + wr * 64 + fr; const int d0 = u.pn * 64 + wc * 16 + 4 * fq;
    u32x2 np[4];
#define E3_LOAD(g_) do { const GAS bf16_t* pr_ = (const GAS bf16_t*)P + (size_t)(row0 + ((g_) >> 2) * HALF + ((g_) & 3) * 16) * 4096 + d0; \
      _Pragma("unroll") for (int br_ = 0; br_ < 4; ++br_) np[br_] = *(const GAS u32x2*)(pr_ + br_ * 1024); } while (0)
    E3_LOAD(0);
#pragma unroll
    for (int ai = 0; ai < 2; ++ai)
#pragma unroll
      for (int m = 0; m < 4; ++m) {
        const int row = row0 + ai * HALF + m * 16;
        const float rsn = -LOG2E * R.get(par, ai * HALF + wr * 64 + m * 16 + fr);
        u32x2 cp[4];
#pragma unroll
        for (int br = 0; br < 4; ++br) cp[br] = np[br];
        if (ai * 4 + m + 1 < 8) E3_LOAD(ai * 4 + m + 1);
        f32x4 sum = {0.f, 0.f, 0.f, 0.f};
#pragma unroll
        for (int bj = 0; bj < 2; ++bj)
#pragma unroll
          for (int n = 0; n < 2; ++n) {
            const u32x2 pv = cp[2 * bj + n];
            const f32x4 a = acc[ai][bj][m][n] * rsn;
            sum[0] += __builtin_amdgcn_rcpf(1.0f + __builtin_amdgcn_exp2f(a[0])) * bf_lo(pv.x); sum[1] += __builtin_amdgcn_rcpf(1.0f + __builtin_amdgcn_exp2f(a[1])) * bf_hi(pv.x);
            sum[2] += __builtin_amdgcn_rcpf(1.0f + __builtin_amdgcn_exp2f(a[2])) * bf_lo(pv.y); sum[3] += __builtin_amdgcn_rcpf(1.0f + __builtin_amdgcn_exp2f(a[3])) * bf_hi(pv.y);
          }
        u32x2 w; w.x = pk_bf16(sum[0], sum[1]); w.y = pk_bf16(sum[2], sum[3]);
        *(u32x2*)(O + (size_t)row * 1024 + d0) = w;
      }
#undef E3_LOAD
    if (has_nx) R.prime(nx, par ^ 1, tid_);
  }
};
template <bool WITH_NEXT> struct Epi4 {
  static constexpr bool PERM = true;
  const float* base; const bf16_t* baseb; bf16_t* xb; float* stn; const float* wf; LAS unsigned char* lds;
  __device__ __forceinline__ void pre(const Unit&, int, int) const {}
  __device__ __forceinline__ void operator()(const f32x4 (&acc)[2][2][4][2], const Unit& u, int wr, int wc, int fr, int fq, int, bool, const Unit&) const {
    LAS float* redF = (LAS float*)(lds + 3 * HTB);
    LAS float* redS = (LAS float*)(lds + STAGE_BYTES + 1024);
    const int row0 = u.pm * BM + wr * 64 + fr; const int col0 = u.pn * BM + wc * 32 + 8 * fq;
    constexpr int RD = WITH_NEXT ? 1 : 4;
    u32x4 ring[RD][WITH_NEXT ? 4 : 2];
#define E4_LOAD(g_) do { const int row_ = row0 + ((g_) >> 2) * HALF + ((g_) & 3) * 16; const size_t off_ = (size_t)row_ * D + col0; \
      _Pragma("unroll") for (int bj_ = 0; bj_ < 2; ++bj_) { \
        if constexpr (WITH_NEXT) { ring[0][2 * bj_] = __builtin_nontemporal_load((const u32x4*)(base + off_ + bj_ * HALF)); ring[0][2 * bj_ + 1] = __builtin_nontemporal_load((const u32x4*)(base + off_ + bj_ * HALF + 4)); } \
        else ring[(g_) % RD][bj_] = __builtin_nontemporal_load((const u32x4*)(baseb + off_ + bj_ * HALF)); } } while (0)
#pragma unroll
    for (int g0 = 0; g0 < RD; ++g0) E4_LOAD(g0);
#pragma unroll
    for (int ai = 0; ai < 2; ++ai)
#pragma unroll
      for (int m = 0; m < 4; ++m) {
        const int row = row0 + ai * HALF + m * 16; const size_t off = (size_t)row * D + col0;
        float ss = 0.f, f0 = 0.f, f1 = 0.f, f2 = 0.f, f3 = 0.f;
        f32x4 cb[4];
        if constexpr (WITH_NEXT) {
#pragma unroll
          for (int q = 0; q < 4; ++q) cb[q] = __builtin_bit_cast(f32x4, ring[0][q]);
        } else {
#pragma unroll
          for (int bj = 0; bj < 2; ++bj) { const u32x4 w_ = ring[(ai * 4 + m) % RD][bj]; cb[2 * bj] = (f32x4){bf_lo(w_.x), bf_hi(w_.x), bf_lo(w_.y), bf_hi(w_.y)}; cb[2 * bj + 1] = (f32x4){bf_lo(w_.z), bf_hi(w_.z), bf_lo(w_.w), bf_hi(w_.w)}; }
        }
        if (ai * 4 + m + RD < 8) E4_LOAD(ai * 4 + m + RD);
#pragma unroll
        for (int bj = 0; bj < 2; ++bj) {
          const f32x4 x0 = cb[2 * bj] + acc[ai][bj][m][0], x1 = cb[2 * bj + 1] + acc[ai][bj][m][1];
          ss += ((x0[0] * x0[0] + x0[1] * x0[1]) + (x0[2] * x0[2] + x0[3] * x0[3])) + ((x1[0] * x1[0] + x1[1] * x1[1]) + (x1[2] * x1[2] + x1[3] * x1[3]));
          { u32x4 w; w.x = pk_bf16(x0[0], x0[1]); w.y = pk_bf16(x0[2], x0[3]); w.z = pk_bf16(x1[0], x1[1]); w.w = pk_bf16(x1[2], x1[3]); *(u32x4*)(xb + off + bj * HALF) = w; }
          if (WITH_NEXT) {
#pragma unroll
            for (int j = 0; j < 4; ++j) { const f32x4 wv = *(const f32x4*)(wf + (size_t)(col0 + bj * HALF + j) * 4); f0 += x0[j] * wv[0]; f1 += x0[j] * wv[1]; f2 += x0[j] * wv[2]; f3 += x0[j] * wv[3]; }
#pragma unroll
            for (int j = 0; j < 4; ++j) { const f32x4 wv = *(const f32x4*)(wf + (size_t)(col0 + bj * HALF + 4 + j) * 4); f0 += x1[j] * wv[0]; f1 += x1[j] * wv[1]; f2 += x1[j] * wv[2]; f3 += x1[j] * wv[3]; }
          }
        }
        ss += __shfl_xor(ss, 16); ss += __shfl_xor(ss, 32);
        if (WITH_NEXT) { f0 += __shfl_xor(f0, 16); f0 += __shfl_xor(f0, 32); f1 += __shfl_xor(f1, 16); f1 += __shfl_xor(f1, 32);
                         f2 += __shfl_xor(f2, 16); f2 += __shfl_xor(f2, 32); f3 += __shfl_xor(f3, 16); f3 += __shfl_xor(f3, 32); }
        if (fq == 0) {
          const int rl = ai * HALF + wr * 64 + m * 16 + fr;
          redS[wc * 256 + rl] = ss;
          if (WITH_NEXT) { redF[(0 * 4 + wc) * 256 + rl] = f0; redF[(1 * 4 + wc) * 256 + rl] = f1; redF[(2 * 4 + wc) * 256 + rl] = f2; redF[(3 * 4 + wc) * 256 + rl] = f3; }
        }
      }
#undef E4_LOAD
    asm volatile("s_waitcnt lgkmcnt(0)" ::: "memory"); __builtin_amdgcn_s_barrier(); asm volatile("" ::: "memory");
    {
      const int t = (wr * 4 + wc) * 64 + fq * 16 + fr; const int rl = t & 255, part = t >> 8;
      float* dst = stn + ((size_t)(u.pm * BM + rl) * 4 + u.pn) * 8;
      if (part == 0) {
        dst[0] = (redS[rl] + redS[256 + rl]) + (redS[512 + rl] + redS[768 + rl]);
        if (WITH_NEXT) { dst[1] = (redF[rl] + redF[256 + rl]) + (redF[512 + rl] + redF[768 + rl]);
                         dst[2] = (redF[1024 + rl] + redF[1280 + rl]) + (redF[1536 + rl] + redF[1792 + rl]); }
      } else if (WITH_NEXT) {
        dst[3] = (redF[2048 + rl] + redF[2304 + rl]) + (redF[2560 + rl] + redF[2816 + rl]);
        dst[4] = (redF[3072 + rl] + redF[3328 + rl]) + (redF[3584 + rl] + redF[3840 + rl]);
      }
    }
    asm volatile("s_waitcnt lgkmcnt(0)" ::: "memory"); __builtin_amdgcn_s_barrier(); asm volatile("" ::: "memory");
  }
};

template <class Epi, class Sched, bool ALIGN_EPI = true>
__device__ __forceinline__ void gemm_phase(LAS unsigned char* lds, const Gemm g, const Sched& S, const Epi& E) {
  const int tid = opaque_v((int)threadIdx.x), wid = __builtin_amdgcn_readfirstlane(tid >> 6), lane = tid & 63, wr = wid >> 2, wc = wid & 3, fr = lane & 15, fq = lane >> 4;
  const int K = g.K, nt = K / BK;
  unsigned voffA[2], voffB[2];
#pragma unroll
  for (int i = 0; i < 2; ++i) { int R, C; stage_rc(tid * 16 + i * 8192, R, C); const int Rb = Epi::PERM ? ((R & ~31) + perm32(R & 31)) : R;
    voffA[i] = (unsigned)(R * g.lda + C) * 2u; voffB[i] = (unsigned)(Rb * g.ldb + C) * 2u; }
  const size_t kstep = (size_t)(BK * 2);
  const size_t hstepA = (size_t)HALF * g.lda * 2, hstepB = (size_t)HALF * g.ldb * 2;
  const unsigned ldsw = (unsigned)wid * 1024u;
  const int aoff = lds_byte(wr * 64 + fr, fq * 8), boff = lds_byte(wc * 32 + fr, fq * 8);
#define PG8_SA(b, h) (((b) * 2 + (h)) * HTB)
#define PG8_SB(b, h) ((4 + (b) * 2 + (h)) * HTB)
#define PG8_STAGE(bufoff, gbase, voff) do { _Pragma("unroll") for (int _i = 0; _i < 2; ++_i) \
    __builtin_amdgcn_global_load_lds((const unsigned*)((const char*)(gbase) + (voff)[_i]), (LAS unsigned*)(lds + (bufoff) + ldsw + _i * 8192), 16, 0, 0); } while (0)
#define PG8_LDA(dst, b, h) do { _Pragma("unroll") for (int m = 0; m < 4; ++m) _Pragma("unroll") for (int k = 0; k < 2; ++k) dst[m][k] = *(const LAS bf16x8*)(lds + PG8_SA(b, h) + aoff + m * 2048 + k * 1024); } while (0)
#define PG8_LDB(dst, b, h) do { _Pragma("unroll") for (int n = 0; n < 2; ++n) _Pragma("unroll") for (int k = 0; k < 2; ++k) dst[n][k] = *(const LAS bf16x8*)(lds + PG8_SB(b, h) + boff + n * 2048 + k * 1024); } while (0)
#define PG8_MMA(ai, bj, At, Bt) do { __builtin_amdgcn_s_setprio(1); _Pragma("unroll") for (int m = 0; m < 4; ++m) _Pragma("unroll") for (int n = 0; n < 2; ++n) _Pragma("unroll") for (int k = 0; k < 2; ++k) \
    acc[ai][bj][m][n] = __builtin_amdgcn_mfma_f32_16x16x32_bf16(Bt[n][k], At[m][k], acc[ai][bj][m][n], 0, 0, 0); __builtin_amdgcn_s_setprio(0); } while (0)
#define PG8_WAIT_V(n) asm volatile("s_waitcnt vmcnt(" #n ")" ::: "memory")
#define PG8_WAIT_L(n) asm volatile("s_waitcnt lgkmcnt(" #n ")" ::: "memory")
#define PG8_BAR __builtin_amdgcn_s_barrier()
#define PG8_SCHED __builtin_amdgcn_sched_barrier(0)
  Unit cur, nxt; int ui = 0;
  if (!S.next(0, cur)) return;
  E.pre(cur, 0, tid);
  f32x4 acc[2][2][4][2];
#pragma unroll
  for (int a = 0; a < 2; ++a)
#pragma unroll
    for (int b = 0; b < 2; ++b)
#pragma unroll
      for (int m = 0; m < 4; ++m)
#pragma unroll
        for (int n = 0; n < 2; ++n) acc[a][b][m][n] = (f32x4){0.f, 0.f, 0.f, 0.f};
  bf16x8 At[4][2], B0[2][2], B1[2][2];
  const char* cA = (const char*)g.A + cur.a_byte; const char* cB = (const char*)g.Bt + cur.b_byte;
  PG8_STAGE(PG8_SB(0, 0), cB, voffB); PG8_STAGE(PG8_SB(0, 1), cB + hstepB, voffB); PG8_STAGE(PG8_SA(0, 0), cA, voffA); PG8_STAGE(PG8_SA(0, 1), cA + hstepA, voffA);
  if (wr == 1) PG8_BAR;
  PG8_WAIT_V(2); PG8_BAR;
  PG8_STAGE(PG8_SB(1, 0), cB + kstep, voffB); PG8_STAGE(PG8_SA(1, 0), cA + kstep, voffA); PG8_STAGE(PG8_SB(1, 1), cB + hstepB + kstep, voffB);
  PG8_WAIT_V(6); PG8_BAR;
  for (;;) {
    const bool has_next = S.next(ui + 1, nxt);
    const char* nA = has_next ? (const char*)g.A + nxt.a_byte : cA; const char* nB = has_next ? (const char*)g.Bt + nxt.b_byte : cB;
#pragma unroll 1
    for (int t = 0; t < nt; t += 2) {
      const bool last = (t == nt - 2);
      const char* a1 = cA + (size_t)(t + 1) * kstep;
      const char* a2 = last ? nA : cA + (size_t)(t + 2) * kstep; const char* b2 = last ? nB : cB + (size_t)(t + 2) * kstep;
      const char* a3 = a2 + kstep; const char* b3 = b2 + kstep;
      PG8_LDB(B0, 0, 0); PG8_LDB(B1, 0, 1); PG8_SCHED; PG8_LDA(At, 0, 0); PG8_STAGE(PG8_SA(1, 1), a1 + hstepA, voffA);
      PG8_WAIT_V(8); PG8_WAIT_L(0); PG8_BAR; PG8_MMA(0, 0, At, B0); PG8_MMA(0, 1, At, B1); PG8_BAR; PG8_SCHED;
      PG8_LDA(At, 0, 1); PG8_STAGE(PG8_SB(0, 0), b2, voffB); PG8_STAGE(PG8_SB(0, 1), b2 + hstepB, voffB); PG8_STAGE(PG8_SA(0, 0), a2, voffA);
      PG8_WAIT_V(8); PG8_WAIT_L(0); PG8_BAR; PG8_MMA(1, 0, At, B0); PG8_MMA(1, 1, At, B1); PG8_BAR; PG8_SCHED;
      PG8_LDB(B0, 1, 0); PG8_LDB(B1, 1, 1); PG8_SCHED; PG8_LDA(At, 1, 0); PG8_STAGE(PG8_SA(0, 1), a2 + hstepA, voffA);
      PG8_WAIT_V(8); PG8_WAIT_L(0); PG8_BAR; PG8_MMA(0, 0, At, B0); PG8_MMA(0, 1, At, B1); PG8_BAR; PG8_SCHED;
      PG8_LDA(At, 1, 1); PG8_STAGE(PG8_SB(1, 0), b3, voffB); PG8_STAGE(PG8_SB(1, 1), b3 + hstepB, voffB); PG8_STAGE(PG8_SA(1, 0), a3, voffA);
      PG8_WAIT_V(8); PG8_WAIT_L(0); PG8_BAR; PG8_MMA(1, 0, At, B0); PG8_MMA(1, 1, At, B1); PG8_BAR; PG8_SCHED;
    }
    if constexpr (ALIGN_EPI) { if (wr == 0) PG8_BAR; }
    E(acc, cur, wr, wc, fr, fq, ui & 1, has_next, nxt);
    if (!has_next) break;
#pragma unroll
    for (int a = 0; a < 2; ++a)
#pragma unroll
      for (int b = 0; b < 2; ++b)
#pragma unroll
        for (int m = 0; m < 4; ++m)
#pragma unroll
          for (int n = 0; n < 2; ++n) acc[a][b][m][n] = (f32x4){0.f, 0.f, 0.f, 0.f};
    cur = nxt; cA = nA; cB = nB; ++ui;
    if constexpr (ALIGN_EPI) { if (wr == 1) PG8_BAR; }
  }
  PG8_WAIT_V(0);
  if constexpr (!ALIGN_EPI) { if (wr == 0) PG8_BAR; }
  PG8_BAR;
#undef PG8_SA
#undef PG8_SB
#undef PG8_STAGE
#undef PG8_LDA
#undef PG8_LDB
#undef PG8_MMA
#undef PG8_WAIT_V
#undef PG8_WAIT_L
#undef PG8_BAR
#undef PG8_SCHED
}
}

__device__ __forceinline__ float wave_sum(float v) {
#pragma unroll
  for (int o = 1; o < 64; o <<= 1) v += __shfl_xor(v, o);
  return v;
}
__device__ __forceinline__ void transpose_item(const float* __restrict__ W, int ldw, int srccol, const float* __restrict__ gs, bf16_t* __restrict__ WT, int K, int k0, int n0,
                                               LAS float* scr, int lane) {
  float tv[32];
#pragma unroll
  for (int i = 0; i < 32; ++i) { const int kk = 2 * i + (lane >> 5); tv[i] = __builtin_nontemporal_load(&W[(size_t)(k0 + kk) * ldw + srccol]); }
  if (gs) {
#pragma unroll
    for (int i = 0; i < 32; ++i) tv[i] *= gs[k0 + 2 * i + (lane >> 5)];
  }
#pragma unroll
  for (int i = 0; i < 32; ++i) { const int kk = 2 * i + (lane >> 5); scr[kk * 33 + (lane & 31)] = tv[i]; }
  asm volatile("s_waitcnt lgkmcnt(0)" ::: "memory");
  const int c = lane & 7;
#pragma unroll
  for (int j = 0; j < 4; ++j) { const int n = (lane >> 3) + 8 * j; const LAS float* s = scr + (8 * c) * 33 + n;
    u32x4 o; o.x = pk_bf16(s[0 * 33], s[1 * 33]); o.y = pk_bf16(s[2 * 33], s[3 * 33]); o.z = pk_bf16(s[4 * 33], s[5 * 33]); o.w = pk_bf16(s[6 * 33], s[7 * 33]);
    *(u32x4*)(WT + (size_t)(n0 + n) * K + k0 + 8 * c) = o; }
  asm volatile("s_waitcnt lgkmcnt(0)" ::: "memory");
}

struct Params {
  const float *x, *norm_g, *w_in, *f_bias, *sgu_w, *sgu_b, *sgu_ln_g, *sgu_ln_b, *short_conv_w, *conf_dw_w, *conf_dw_b, *conf_ln_g, *conf_ln_b, *w_branch, *w_out, *final_g;
  float* out; unsigned char* ws;
};

constexpr int I_W1 = 16 * 112, I_WM = 16 * 128, I_WB = 4 * 4 * 32, I_WO = 16 * 32, I_L = I_W1 + I_WM + I_WB + I_WO;
__device__ __forceinline__ void weight_item(const Params& p, int l, int r, LAS float* scr, int lane) {
  unsigned char* ws = p.ws;
  const float* gl = p.norm_g + l * D;
  const float* win = p.w_in + (size_t)l * D * INC;
  if (r < I_W1) { const int kb = r / 112, nb = r % 112, n0 = 32 * nb; const int n = n0 + (lane & 31); const int col = n < 1536 ? n : n + 4;
    transpose_item(win, INC, col, gl, (bf16_t*)(ws + WS_W1T) + (size_t)l * NP * D, D, 64 * kb, n0, scr, lane); return; }
  r -= I_W1;
  if (r < I_WM) { const int kb = r / 128, nb = r % 128, n0 = 32 * nb; const int c = (n0 & 255) + (lane & 31), pnn = n0 >> 8;
    const int bj = c >> 7, wc = (c >> 5) & 3, n = (c >> 4) & 1, low = c & 15; const int col = 3588 + (2 * bj + n) * 1024 + 64 * pnn + 16 * wc + low;
    transpose_item(win, INC, col, gl, (bf16_t*)(ws + WS_WMT) + (size_t)l * 4096 * D, D, 64 * kb, n0, scr, lane); return; }
  r -= I_WM;
  if (r < I_WB) { const int br = r / 128, q = r % 128, kb = q / 32, nb = q % 32, n0 = 32 * nb;
    transpose_item(p.w_branch + ((size_t)l * 4 + br) * 256 * D, D, n0 + (lane & 31), nullptr, (bf16_t*)(ws + WS_WBT) + ((size_t)l * 4 + br) * D * 256, 256, 64 * kb, n0, scr, lane); return; }
  r -= I_WB;
  { const int kb = r / 32, nb = r % 32, n0 = 32 * nb;
    transpose_item(p.w_out + (size_t)l * D * D, D, n0 + (lane & 31), nullptr, (bf16_t*)(ws + WS_WOT) + (size_t)l * D * D, D, 64 * kb, n0, scr, lane); }
}

__device__ __forceinline__ void p0_prologue(const Params& p, LAS unsigned char* lds, int tid, int lane, int wid, int G, int bx) {
  unsigned char* ws = p.ws;
  LAS float* scr = (LAS float*)(lds + wid * 16384);
  const int gw = bx * 8 + wid, NGW = G * 8;
  for (int it = gw; it < I_L; it += NGW) weight_item(p, 0, it, scr, lane);
  const int gt = bx * 512 + tid, GT = G * 512;
  for (int i = gt; i < 2 * D * 4; i += GT) { const int l = i / (D * 4), k = (i >> 2) & (D - 1), h = i & 3;
    ((float*)(ws + WS_WF))[i] = p.norm_g[l * D + k] * p.w_in[((size_t)l * D + k) * INC + 1536 + h]; }
  for (int i = gt; i < 2 * 4 * 128 * 128; i += GT) { const int s = i & 127, t = (i >> 7) & 127; const float v = (s <= t) ? p.sgu_w[i] : 0.f;
    ((bf16_t*)(ws + WS_SGUW))[i] = (bf16_t)(pk_bf16(v, 0.f) & 0xffffu); }
  {
    f32x4 wv[16];
#pragma unroll
    for (int j = 0; j < 4; ++j)
#pragma unroll
      for (int e = 0; e < 4; ++e) { const int k = 256 * j + 4 * lane + e; const f32x4 w4 = *(const f32x4*)(p.w_in + (size_t)k * INC + 1536); wv[4 * j + e] = w4 * p.norm_g[k]; }
    float* stats = (float*)(ws + WS_STATS);
    bf16_t* xb = (bf16_t*)(ws + WS_XB);
    for (int mm = gw; mm < M; mm += 2 * NGW) {
      const int m2 = mm + NGW; const bool has2 = m2 < M;
      f32x4 va[4], vb[4];
      { const f32x4* xr = (const f32x4*)(p.x + (size_t)mm * D) + lane;
#pragma unroll
        for (int j = 0; j < 4; ++j) va[j] = __builtin_nontemporal_load(&xr[64 * j]); }
      if (has2) { const f32x4* xr = (const f32x4*)(p.x + (size_t)m2 * D) + lane;
#pragma unroll
        for (int j = 0; j < 4; ++j) vb[j] = __builtin_nontemporal_load(&xr[64 * j]); }
      else {
#pragma unroll
        for (int j = 0; j < 4; ++j) vb[j] = (f32x4){0.f, 0.f, 0.f, 0.f}; }
#pragma unroll
      for (int rr = 0; rr < 2; ++rr) {
        const int m = rr == 0 ? mm : m2;
        if (rr == 1 && !has2) break;
        float ss = 0.f, f0 = 0.f, f1 = 0.f, f2 = 0.f, f3 = 0.f;
        u32x2* o8 = (u32x2*)(xb + (size_t)m * D) + lane;
#pragma unroll
        for (int j = 0; j < 4; ++j) { const f32x4 v = rr == 0 ? va[j] : vb[j];
          ss += (v[0] * v[0] + v[1] * v[1]) + (v[2] * v[2] + v[3] * v[3]);
#pragma unroll
          for (int e = 0; e < 4; ++e) { const f32x4 w4 = wv[4 * j + e]; f0 += v[e] * w4[0]; f1 += v[e] * w4[1]; f2 += v[e] * w4[2]; f3 += v[e] * w4[3]; }
          u32x2 w; w.x = pk_bf16(v[0], v[1]); w.y = pk_bf16(v[2], v[3]); o8[64 * j] = w; }
        ss = wave_sum(ss); f0 = wave_sum(f0); f1 = wave_sum(f1); f2 = wave_sum(f2); f3 = wave_sum(f3);
        if (lane < SROW) { const float v = lane == 0 ? ss : lane == 1 ? f0 : lane == 2 ? f1 : lane == 3 ? f2 : lane == 4 ? f3 : 0.f; stats[(size_t)m * SROW + lane] = v; }
      }
    }
  }
}

__device__ __forceinline__ void conv_c(const bf16_t* __restrict__ proj, bf16_t* __restrict__ Y, const float* __restrict__ w, int m0, int tid, int pass0) {
  const int c8 = (tid & 31) * 8, rs = tid >> 5;
  float w0[8], w1[8], w2[8];
#pragma unroll
  for (int e = 0; e < 8; ++e) { w0[e] = w[c8 + e]; w1[e] = w[256 + c8 + e]; w2[e] = w[512 + c8 + e]; }
#pragma unroll 4
  for (int pq = 0; pq < 4; ++pq) {
    const int pass = pass0 + pq;
    const int m = m0 + pass * 16 + rs; const int s = m & (SEQ - 1);
    const bf16_t* row = proj + (size_t)m * NP;
    const u32x4 Bv = *(const u32x4*)(row + PC_CB + c8), Gv = *(const u32x4*)(row + PC_CG + c8);
    const u32x4 Cc0 = *(const u32x4*)(row + PC_CC + c8), Xx0 = *(const u32x4*)(row + PC_CX + c8);
    u32x4 Cc1 = {0, 0, 0, 0}, Xx1 = {0, 0, 0, 0}, Cc2 = {0, 0, 0, 0}, Xx2 = {0, 0, 0, 0};
    if (s >= 1) { Cc1 = *(const u32x4*)(row - NP + PC_CC + c8); Xx1 = *(const u32x4*)(row - NP + PC_CX + c8); }
    if (s >= 2) { Cc2 = *(const u32x4*)(row - 2 * NP + PC_CC + c8); Xx2 = *(const u32x4*)(row - 2 * NP + PC_CX + c8); }
    float b[8], g[8], c0[8], x0[8], c1[8], x1[8], c2[8], x2[8], y[8];
    unpack8(Bv, b); unpack8(Gv, g); unpack8(Cc0, c0); unpack8(Xx0, x0); unpack8(Cc1, c1); unpack8(Xx1, x1); unpack8(Cc2, c2); unpack8(Xx2, x2);
#pragma unroll
    for (int e = 0; e < 8; ++e) { const float cv = w0[e] * (c2[e] * x2[e]) + w1[e] * (c1[e] * x1[e]) + w2[e] * (c0[e] * x0[e]); y[e] = b[e] * cv * g[e]; }
    u32x4 o; o.x = pk_bf16(y[0], y[1]); o.y = pk_bf16(y[2], y[3]); o.z = pk_bf16(y[4], y[5]); o.w = pk_bf16(y[6], y[7]);
    *(u32x4*)(Y + (size_t)m * D + 512 + c8) = o;
  }
}

__device__ __forceinline__ void conv_d(LAS unsigned char* lds, const bf16_t* __restrict__ proj, bf16_t* __restrict__ Y, const float* __restrict__ dw, const float* __restrict__ db,
                                       const float* __restrict__ lg, const float* __restrict__ lb, int m0, int tid, int sub0) {
  constexpr int HP = 260, TT = 32, HR = TT + 30;
  LAS float* H = (LAS float*)lds;
  LAS float* YB = (LAS float*)(lds + 65536);
  const int c = tid & 255, tg = tid >> 8;
  float w[31];
#pragma unroll
  for (int k = 0; k < 31; ++k) w[k] = dw[k * 256 + c];
  const float bias = db[c];
  u32x4 ha[4], hs[4];
#define CD_LOAD(mb_) do { const int sb_ = (mb_) & (SEQ - 1); _Pragma("unroll") for (int it = 0; it < 4; ++it) { const int idx = tid + 512 * it; const int j = idx >> 5, c8 = (idx & 31) * 8; \
      ha[it] = (u32x4){0u, 0u, 0u, 0u}; hs[it] = (u32x4){0u, 0u, 0u, 0u}; \
      if (idx < HR * 32 && sb_ + j - 30 >= 0) { const bf16_t* row = proj + (size_t)((mb_) - 30 + j) * NP; ha[it] = *(const u32x4*)(row + PC_DA + c8); hs[it] = *(const u32x4*)(row + PC_DS + c8); } } } while (0)
#define CD_WRITE() do { _Pragma("unroll") for (int it = 0; it < 4; ++it) { const int idx = tid + 512 * it; const int j = idx >> 5, c8 = (idx & 31) * 8; \
      if (idx < HR * 32) { float a[8], sg[8]; unpack8(ha[it], a); unpack8(hs[it], sg); \
        *(LAS f32x4*)(H + j * HP + c8) = (f32x4){a[0] * sg[0], a[1] * sg[1], a[2] * sg[2], a[3] * sg[3]}; *(LAS f32x4*)(H + j * HP + c8 + 4) = (f32x4){a[4] * sg[4], a[5] * sg[5], a[6] * sg[6], a[7] * sg[7]}; } } } while (0)
  CD_LOAD(m0 + sub0 * TT);
#pragma unroll 1
  for (int sub = sub0; sub < sub0 + 2; ++sub) {
    const int mb = m0 + sub * TT;
    CD_WRITE();
    __syncthreads();
    if (sub + 1 < sub0 + 2) CD_LOAD(mb + TT);
    const bf16_t* grow_ = proj + (size_t)(mb + (tid >> 4)) * NP + PC_DG + 16 * (tid & 15);
    const u32x4 gpre0 = *(const u32x4*)(grow_), gpre1 = *(const u32x4*)(grow_ + 8);
#pragma unroll 1
    for (int i = 0; i < 4; ++i) {
      const int tl = tg * 16 + 4 * i;
      float a0 = bias, a1 = bias, a2 = bias, a3 = bias;
#pragma unroll
      for (int k = 0; k < 34; ++k) {
        const float hv = H[(tl + k) * HP + c];
        if (k <= 30) a0 += w[k <= 30 ? k : 0] * hv;
        if (k >= 1 && k <= 31) a1 += w[(k >= 1 && k <= 31) ? k - 1 : 0] * hv;
        if (k >= 2 && k <= 32) a2 += w[(k >= 2 && k <= 32) ? k - 2 : 0] * hv;
        if (k >= 3) a3 += w[k >= 3 ? k - 3 : 0] * hv;
      }
      YB[(tl + 0) * HP + c] = a0; YB[(tl + 1) * HP + c] = a1; YB[(tl + 2) * HP + c] = a2; YB[(tl + 3) * HP + c] = a3;
    }
    __syncthreads();
    {
      const int r = tid >> 4, q = tid & 15; const int m = mb + r;
      f32x4 v[4]; float s1 = 0.f, s2 = 0.f;
#pragma unroll
      for (int e = 0; e < 4; ++e) { v[e] = *(const LAS f32x4*)(YB + r * HP + 16 * q + 4 * e); s1 += (v[e][0] + v[e][1]) + (v[e][2] + v[e][3]);
        s2 += (v[e][0] * v[e][0] + v[e][1] * v[e][1]) + (v[e][2] * v[e][2] + v[e][3] * v[e][3]); }
#pragma unroll
      for (int o = 1; o < 16; o <<= 1) { s1 += __shfl_xor(s1, o); s2 += __shfl_xor(s2, o); }
      const float mu = s1 * (1.0f / 256.0f); const float var = fmaxf(s2 * (1.0f / 256.0f) - mu * mu, 0.f); const float rstd = rsqrtf(var + EPS);
      float gt[16]; unpack8(gpre0, gt); unpack8(gpre1, gt + 8);
      float o[16];
#pragma unroll
      for (int e = 0; e < 4; ++e) { const f32x4 g4 = *(const f32x4*)(lg + 16 * q + 4 * e), b4 = *(const f32x4*)(lb + 16 * q + 4 * e);
#pragma unroll
        for (int j = 0; j < 4; ++j) { const float z = (v[e][j] - mu) * rstd * g4[j] + b4[j]; o[4 * e + j] = z * fast_sigmoid(z) * gt[4 * e + j]; } }
      u32x4 o0, o1; o0.x = pk_bf16(o[0], o[1]); o0.y = pk_bf16(o[2], o[3]); o0.z = pk_bf16(o[4], o[5]); o0.w = pk_bf16(o[6], o[7]);
      o1.x = pk_bf16(o[8], o[9]); o1.y = pk_bf16(o[10], o[11]); o1.z = pk_bf16(o[12], o[13]); o1.w = pk_bf16(o[14], o[15]);
      bf16_t* yo = Y + (size_t)m * D + 768 + 16 * q;
      *(u32x4*)yo = o0; *(u32x4*)(yo + 8) = o1;
    }
    __syncthreads();
  }
#undef CD_LOAD
#undef CD_WRITE
}

__device__ __forceinline__ void gmlp_unit(LAS unsigned char* lds, const bf16_t* __restrict__ proj, bf16_t* __restrict__ Y, const bf16_t* __restrict__ sw  ,
                                          const float* __restrict__ sb  , const float* __restrict__ lg, const float* __restrict__ lb, int m0, int tid) {
  constexpr int VP = 136;
  LAS bf16_t* vnT = (LAS bf16_t*)lds;
  {
    const int r = tid >> 2, q = tid & 3;
    const bf16_t* vrow = proj + (size_t)(m0 + r) * NP + PC_V + 64 * q;
    float v[64]; float s1 = 0.f;
#pragma unroll
    for (int e = 0; e < 8; ++e) { unpack8(__builtin_nontemporal_load((const u32x4*)(vrow + 8 * e)), v + 8 * e); }
#pragma unroll
    for (int e = 0; e < 64; ++e) s1 += v[e];
    s1 += __shfl_xor(s1, 1); s1 += __shfl_xor(s1, 2);
    const float mu = s1 * (1.0f / 256.0f); float s2 = 0.f;
#pragma unroll
    for (int e = 0; e < 64; ++e) { const float d = v[e] - mu; s2 += d * d; }
    s2 += __shfl_xor(s2, 1); s2 += __shfl_xor(s2, 2);
    const float rstd = rsqrtf(s2 * (1.0f / 256.0f) + EPS);
#pragma unroll
    for (int e = 0; e < 64; ++e) { const int ch = 64 * q + e; const float z = (v[e] - mu) * rstd * lg[ch] + lb[ch]; vnT[ch * VP + r] = (bf16_t)(pk_bf16(z, 0.f) & 0xffffu); }
  }
  __syncthreads();
  {
    const int lane = tid & 63, wid = tid >> 6, r32 = lane & 31, hi = lane >> 5; const int h = wid >> 1, th = wid & 1;
    f32x16 acc[2][2];
#pragma unroll
    for (int a = 0; a < 2; ++a)
#pragma unroll
      for (int b = 0; b < 2; ++b)
#pragma unroll
        for (int r = 0; r < 16; ++r) acc[a][b][r] = 0.f;
    const bf16_t* wbase = sw + (size_t)h * 128 * 128 + (size_t)(64 * th + r32) * 128 + 8 * hi;
    const LAS bf16_t* abase = vnT + (64 * h + r32) * VP + 8 * hi;
#pragma unroll
    for (int ks = 0; ks < 8; ++ks) {
      bf16x8 a0 = *(const LAS bf16x8*)(abase + 16 * ks), a1 = *(const LAS bf16x8*)(abase + 32 * VP + 16 * ks);
      bf16x8 b0 = *(const bf16x8*)(wbase + 16 * ks), b1 = *(const bf16x8*)(wbase + 32 * 128 + 16 * ks);
      acc[0][0] = __builtin_amdgcn_mfma_f32_32x32x16_bf16(a0, b0, acc[0][0], 0, 0, 0);
      acc[0][1] = __builtin_amdgcn_mfma_f32_32x32x16_bf16(a0, b1, acc[0][1], 0, 0, 0);
      acc[1][0] = __builtin_amdgcn_mfma_f32_32x32x16_bf16(a1, b0, acc[1][0], 0, 0, 0);
      acc[1][1] = __builtin_amdgcn_mfma_f32_32x32x16_bf16(a1, b1, acc[1][1], 0, 0, 0);
    }
    __syncthreads();
    LAS float* stg = (LAS float*)lds;
#pragma unroll
    for (int tb = 0; tb < 2; ++tb) {
      const int t = 64 * th + 32 * tb + r32; const float bt = sb[h * 128 + t];
#pragma unroll
      for (int db = 0; db < 2; ++db)
#pragma unroll
        for (int g = 0; g < 4; ++g) {
          const int chunk = (64 * h + 32 * db + 8 * g + 4 * hi) >> 2;
          *(LAS f32x4*)(stg + t * 256 + ((chunk ^ (t & 63)) << 2)) = (f32x4){acc[db][tb][4 * g + 0] + bt, acc[db][tb][4 * g + 1] + bt, acc[db][tb][4 * g + 2] + bt, acc[db][tb][4 * g + 3] + bt};
        }
    }
    __syncthreads();
    {
      const int c8 = (tid & 31) * 8, rs = tid >> 5;
#pragma unroll 4
      for (int pass = 0; pass < 8; ++pass) {
        const int t = pass * 16 + rs;
        const bf16_t* prow = proj + (size_t)(m0 + t) * NP;
        float uu[8], gg[8]; unpack8(__builtin_nontemporal_load((const u32x4*)(prow + PC_U + c8)), uu); unpack8(__builtin_nontemporal_load((const u32x4*)(prow + PC_AG + c8)), gg);
        const int ck = c8 >> 2;
        const f32x4 a = *(const LAS f32x4*)(stg + t * 256 + ((ck ^ (t & 63)) << 2)), c = *(const LAS f32x4*)(stg + t * 256 + (((ck + 1) ^ (t & 63)) << 2));
        u32x4 o; o.x = pk_bf16(uu[0] * a[0] * gg[0], uu[1] * a[1] * gg[1]); o.y = pk_bf16(uu[2] * a[2] * gg[2], uu[3] * a[3] * gg[3]);
        o.z = pk_bf16(uu[4] * c[0] * gg[4], uu[5] * c[1] * gg[5]); o.w = pk_bf16(uu[6] * c[2] * gg[6], uu[7] * c[3] * gg[7]);
        *(u32x4*)(Y + (size_t)(m0 + t) * D + c8) = o;
      }
    }
  }
  __syncthreads();
}

constexpr int AT_K = 0, AT_V = 16384, AT_CUM = 40960, AT_WSF = 57344, AT_SCAN = 59392, AT_OST = 61440;
constexpr float SKIP_THR = 100.0f, THRL = 64.0f;
__device__ __forceinline__ int crow(int r, int hi) { return (r & 3) + 8 * (r >> 2) + 4 * hi; }
__device__ __forceinline__ unsigned bf_rne(float v) { return pk_bf16(v, 0.f) & 0xffffu; }
__device__ __forceinline__ bf16x8 split3(float v, bool first, bool active) {
  const unsigned h = bf_rne(v); const float r1 = v - __uint_as_float(h << 16);
  const unsigned m = bf_rne(r1); const float r2 = r1 - __uint_as_float(m << 16);
  const unsigned l = bf_rne(r2);
  const unsigned one = 0x3f80u;
  u32x4 w;
  if (first) { w.x = h | (m << 16); w.y = l | (one << 16); w.z = one | (one << 16); w.w = 0u; }
  else       { w.x = one | (one << 16); w.y = one | (h << 16); w.z = m | (l << 16); w.w = 0u; }
  if (!active) { w.x = 0u; w.y = 0u; w.z = 0u; }
  return __builtin_bit_cast(bf16x8, w);
}

struct AttnState { float mhat, lsum; f32x16 o0, o1; bf16x8 qx; };

struct AttnP { bf16x8 pa[4]; bool resc; };
__device__ __forceinline__ void attn_front(AttnState& S, AttnP& P, const LAS unsigned char* Ks, const LAS float* cum, LAS float* wsf, const bf16x8 (&qr)[4],
                                           float cref, int t, int q0w, int qrow, int r32, int hi) {
  const bf16x8 kx0 = split3(cref - cum[64 * t + r32], true, hi == 0), kx1 = split3(cref - cum[64 * t + 32 + r32], true, hi == 0);
  f32x16 p0, p1;
#pragma unroll
  for (int r = 0; r < 16; ++r) { p0[r] = 0.f; p1[r] = 0.f; }
  p0 = __builtin_amdgcn_mfma_f32_32x32x16_bf16(kx0, S.qx, p0, 0, 0, 0);
  p1 = __builtin_amdgcn_mfma_f32_32x32x16_bf16(kx1, S.qx, p1, 0, 0, 0);
  const LAS unsigned char* kb = Ks + hi * 1024 + r32 * 16;
#pragma unroll
  for (int d0 = 0; d0 < 4; ++d0) {
    const bf16x8 k0 = *(const LAS bf16x8*)(kb + d0 * 2048), k1 = *(const LAS bf16x8*)(kb + d0 * 2048 + 512);
    p0 = __builtin_amdgcn_mfma_f32_32x32x16_bf16(k0, qr[d0], p0, 0, 0, 0);
    p1 = __builtin_amdgcn_mfma_f32_32x32x16_bf16(k1, qr[d0], p1, 0, 0, 0);
  }
  if (64 * t + 63 > q0w) {
#pragma unroll
    for (int r = 0; r < 16; ++r) { const int kv = 64 * t + crow(r, hi); if (kv > qrow) p0[r] = -INFINITY; if (kv + 32 > qrow) p1[r] = -INFINITY; }
  }
  float rm = fmaxf(fmaxf(p0[0], p0[1]), p1[0]);
#pragma unroll
  for (int r = 2; r < 16; r += 2) rm = fmaxf(fmaxf(rm, p0[r]), p0[r + 1]);
#pragma unroll
  for (int r = 1; r < 16; r += 2) rm = fmaxf(fmaxf(rm, p1[r]), p1[(r + 1) & 15]);
  rm = fmaxf(rm, __shfl_xor(rm, 32));
  const bool resc = __any(rm > THRL);
  if (resc) {
    const float dl = fmaxf(rm, 0.f); S.mhat += dl;
#pragma unroll
    for (int r = 0; r < 16; ++r) { p0[r] -= dl; p1[r] -= dl; }
    const float f = __builtin_amdgcn_exp2f(-dl); S.lsum *= f;
    if (hi == 0) wsf[r32] = f;
    S.qx = split3(-S.mhat, false, hi == 0);
  }
  float ps = 0.f;
#pragma unroll
  for (int r = 0; r < 16; ++r) { p0[r] = __builtin_amdgcn_exp2f(p0[r]); p1[r] = __builtin_amdgcn_exp2f(p1[r]); ps += p0[r] + p1[r]; }
  S.lsum += ps;
  { u32x4 w;
    w.x = pk_bf16(p0[0], p0[1]); w.y = pk_bf16(p0[2], p0[3]); w.z = pk_bf16(p0[4], p0[5]); w.w = pk_bf16(p0[6], p0[7]); P.pa[0] = __builtin_bit_cast(bf16x8, w);
    w.x = pk_bf16(p0[8], p0[9]); w.y = pk_bf16(p0[10], p0[11]); w.z = pk_bf16(p0[12], p0[13]); w.w = pk_bf16(p0[14], p0[15]); P.pa[1] = __builtin_bit_cast(bf16x8, w);
    w.x = pk_bf16(p1[0], p1[1]); w.y = pk_bf16(p1[2], p1[3]); w.z = pk_bf16(p1[4], p1[5]); w.w = pk_bf16(p1[6], p1[7]); P.pa[2] = __builtin_bit_cast(bf16x8, w);
    w.x = pk_bf16(p1[8], p1[9]); w.y = pk_bf16(p1[10], p1[11]); w.z = pk_bf16(p1[12], p1[13]); w.w = pk_bf16(p1[14], p1[15]); P.pa[3] = __builtin_bit_cast(bf16x8, w); }
  P.resc = resc;
}

__device__ __forceinline__ void attn_back(AttnState& S, const AttnP& P, const LAS unsigned char* Vs, const LAS float* wsf, int lane, int hi) {
  const bool resc = P.resc;
  if (resc) {
#pragma unroll
    for (int g = 0; g < 4; ++g) { const f32x4 ff = *(const LAS f32x4*)(wsf + 8 * g + 4 * hi);
#pragma unroll
      for (int j = 0; j < 4; ++j) { S.o0[4 * g + j] *= ff[j]; S.o1[4 * g + j] *= ff[j]; } }
  }
  const LAS unsigned char* vb = Vs + ((lane >> 4) & 1) * 32 + (lane & 3) * 8 + (4 * hi + ((lane & 15) >> 2)) * 64;
  s16x4 lo0[4], hh0[4], lo1[4], hh1[4];
#pragma unroll
  for (int ks = 0; ks < 4; ++ks) {
    lo0[ks] = __builtin_bit_cast(s16x4, __builtin_amdgcn_ds_read_tr16_b64_v4i16((LAS s16x4*)(vb + ks * 1024)));
    hh0[ks] = __builtin_bit_cast(s16x4, __builtin_amdgcn_ds_read_tr16_b64_v4i16((LAS s16x4*)(vb + ks * 1024 + 512)));
    lo1[ks] = __builtin_bit_cast(s16x4, __builtin_amdgcn_ds_read_tr16_b64_v4i16((LAS s16x4*)(vb + 4096 + ks * 1024)));
    hh1[ks] = __builtin_bit_cast(s16x4, __builtin_amdgcn_ds_read_tr16_b64_v4i16((LAS s16x4*)(vb + 4096 + ks * 1024 + 512)));
  }
  asm volatile("s_waitcnt lgkmcnt(0)" ::: "memory");
#pragma unroll
  for (int ks = 0; ks < 4; ++ks) {
    const bf16x8 v0 = {lo0[ks][0], lo0[ks][1], lo0[ks][2], lo0[ks][3], hh0[ks][0], hh0[ks][1], hh0[ks][2], hh0[ks][3]};
    const bf16x8 v1 = {lo1[ks][0], lo1[ks][1], lo1[ks][2], lo1[ks][3], hh1[ks][0], hh1[ks][1], hh1[ks][2], hh1[ks][3]};
    S.o0 = __builtin_amdgcn_mfma_f32_32x32x16_bf16(P.pa[ks], v0, S.o0, 0, 0, 0);
    S.o1 = __builtin_amdgcn_mfma_f32_32x32x16_bf16(P.pa[ks], v1, S.o1, 0, 0, 0);
  }
}

__device__ __forceinline__ void attn_unit(LAS unsigned char* lds, const bf16_t* __restrict__ proj, bf16_t* __restrict__ Y, const float* __restrict__ stats, float fbias,
                                          int b, int h, int qb, int tid, bool do_scan) {
  const int lane = tid & 63, wid = __builtin_amdgcn_readfirstlane(tid >> 6), r32 = lane & 31, hi = lane >> 5;
  const int q0 = qb * 256; const size_t rowbase = (size_t)b * SEQ;
  LAS float* cum = (LAS float*)(lds + AT_CUM);
  LAS float* wsf = (LAS float*)(lds + AT_WSF) + wid * 64;
  LAS float* scan = (LAS float*)(lds + AT_SCAN);
  const int NT = (q0 + 256) / 64;
  const int qrow = q0 + wid * 32 + r32;
  const bf16_t* Qw = proj + (rowbase + qrow) * NP + PC_Q + h * 64;
  bf16x8 qr[4];
#pragma unroll
  for (int d0 = 0; d0 < 4; ++d0) qr[d0] = __builtin_nontemporal_load((const bf16x8*)(Qw + d0 * 16 + hi * 8));
  if (do_scan) {
    const int i0 = tid * 8; float lf[8]; float run = 0.f;
#pragma unroll
    for (int e = 0; e < 8; ++e) {
      float v = 0.f;
      if (i0 + e < q0 + 256) { const float* st = stats + (rowbase + i0 + e) * SROW; const float rs = row_rstd(st); const float z = rs * ((st[1 + h] + st[9 + h]) + (st[17 + h] + st[25 + h])) + fbias;
        v = fminf(z, 0.f) - 0.6931471805599453f * __builtin_amdgcn_logf(1.0f + __builtin_amdgcn_exp2f(-LOG2E * fabsf(z))); }
      run += v; lf[e] = run;
    }
    float incl = run;
#pragma unroll
    for (int o = 1; o < 64; o <<= 1) { const float n = __shfl_up(incl, o); if (lane >= o) incl += n; }
    if (lane == 63) scan[wid] = incl;
    __syncthreads();
    float woff = 0.f;
#pragma unroll
    for (int w = 0; w < 8; ++w) if (w < wid) woff += scan[w];
    const float excl = woff + incl - run;
    f32x4 c0 = {(excl + lf[0]) * LOG2E, (excl + lf[1]) * LOG2E, (excl + lf[2]) * LOG2E, (excl + lf[3]) * LOG2E};
    f32x4 c1 = {(excl + lf[4]) * LOG2E, (excl + lf[5]) * LOG2E, (excl + lf[6]) * LOG2E, (excl + lf[7]) * LOG2E};
    *(LAS f32x4*)(cum + i0) = c0; *(LAS f32x4*)(cum + i0 + 4) = c1;
  }
  __syncthreads();
  const float cref = cum[q0];
  int t0;
  { const bool ok = (lane < NT) ? (cum[64 * lane + 63] - cref <= SKIP_THR) : false; const unsigned long long mk = __ballot(ok); t0 = __builtin_amdgcn_readfirstlane((int)__builtin_ctzll(mk)); }
  const bf16_t* Kh = proj + rowbase * NP + PC_K + h * 64; const bf16_t* Vh = proj + rowbase * NP + PC_VV + h * 64;
  const bf16_t* ksrc = Kh + (size_t)lane * NP + wid * 8;
  const bf16_t* vsrc = Vh + (size_t)((tid >> 2) & 63) * NP + (tid >> 8) * 32 + (tid & 3) * 8;
  u32x4 kA = *(const u32x4*)(ksrc + (size_t)t0 * 64 * NP), vA = *(const u32x4*)(vsrc + (size_t)t0 * 64 * NP), kB = kA, vB = vA;
  if (t0 + 1 < NT) { kB = *(const u32x4*)(ksrc + (size_t)(t0 + 1) * 64 * NP); vB = *(const u32x4*)(vsrc + (size_t)(t0 + 1) * 64 * NP); }
  *(LAS u32x4*)(lds + AT_K + tid * 16) = kA; *(LAS u32x4*)(lds + AT_V + tid * 16) = vA;
  __syncthreads();
  AttnState S; S.mhat = 0.f; S.lsum = 0.f;
#pragma unroll
  for (int r = 0; r < 16; ++r) { S.o0[r] = 0.f; S.o1[r] = 0.f; }
  S.qx = split3(0.f, false, hi == 0);
  const int q0w = q0 + wid * 32, qmax_w = q0w + 31;
  const bool late = wid >= 4;
  AttnP Pc; Pc.resc = false; bool pend = false; int vprev = 0;
#pragma unroll
  for (int k = 0; k < 4; ++k) Pc.pa[k] = (bf16x8){0, 0, 0, 0, 0, 0, 0, 0};
  int vs = 0;
#pragma unroll 1
  for (int t = t0; t < NT; t += 2) {
    if (t + 2 < NT) { kA = *(const u32x4*)(ksrc + (size_t)(t + 2) * 64 * NP); vA = *(const u32x4*)(vsrc + (size_t)(t + 2) * 64 * NP); }
    if (late && pend) { attn_back(S, Pc, lds + AT_V + vprev * 8192, wsf, lane, hi); pend = false; }
    if (64 * t <= qmax_w) {
      attn_front(S, Pc, lds + AT_K, cum, wsf, qr, cref, t, q0w, qrow, r32, hi);
      if (!late) attn_back(S, Pc, lds + AT_V + vs * 8192, wsf, lane, hi); else { pend = true; vprev = vs; }
    }
    { const int vn = (vs == 2) ? 0 : vs + 1;
      if (t + 1 < NT) { *(LAS u32x4*)(lds + AT_K + 8192 + tid * 16) = kB; *(LAS u32x4*)(lds + AT_V + vn * 8192 + tid * 16) = vB; }
      vs = vn; }
    __syncthreads();
    if (t + 1 >= NT) break;
    if (t + 3 < NT) { kB = *(const u32x4*)(ksrc + (size_t)(t + 3) * 64 * NP); vB = *(const u32x4*)(vsrc + (size_t)(t + 3) * 64 * NP); }
    if (late && pend) { attn_back(S, Pc, lds + AT_V + vprev * 8192, wsf, lane, hi); pend = false; }
    if (64 * (t + 1) <= qmax_w) {
      attn_front(S, Pc, lds + AT_K + 8192, cum, wsf, qr, cref, t + 1, q0w, qrow, r32, hi);
      if (!late) attn_back(S, Pc, lds + AT_V + vs * 8192, wsf, lane, hi); else { pend = true; vprev = vs; }
    }
    { const int vn = (vs == 2) ? 0 : vs + 1;
      if (t + 2 < NT) { *(LAS u32x4*)(lds + AT_K + tid * 16) = kA; *(LAS u32x4*)(lds + AT_V + vn * 8192 + tid * 16) = vA; }
      vs = vn; }
    __syncthreads();
  }
  if (late && pend) attn_back(S, Pc, lds + AT_V + vprev * 8192, wsf, lane, hi);
  float lsum = S.lsum; lsum += __shfl_xor(lsum, 32);
  if (hi == 0) wsf[r32] = __builtin_amdgcn_rcpf(lsum);
  LAS float* stg = (LAS float*)(lds + AT_OST) + wid * 2048;
#pragma unroll
  for (int g = 0; g < 4; ++g) { const f32x4 ff = *(const LAS f32x4*)(wsf + 8 * g + 4 * hi);
#pragma unroll
    for (int j = 0; j < 4; ++j) { const int q = 8 * g + 4 * hi + j; stg[q * 64 + r32] = S.o0[4 * g + j] * ff[j]; stg[q * 64 + 32 + r32] = S.o1[4 * g + j] * ff[j]; } }
#pragma unroll
  for (int i = 0; i < 4; ++i) {
    const int row = i * 8 + (lane >> 3), ch = lane & 7;
    const f32x4 a = *(const LAS f32x4*)(stg + row * 64 + ch * 8), c = *(const LAS f32x4*)(stg + row * 64 + ch * 8 + 4);
    const size_t grow = rowbase + q0 + wid * 32 + row;
    float gt[8]; unpack8(__builtin_nontemporal_load((const u32x4*)(proj + grow * NP + PC_BG + h * 64 + ch * 8)), gt);
    u32x4 w; w.x = pk_bf16(a[0] * gt[0], a[1] * gt[1]); w.y = pk_bf16(a[2] * gt[2], a[3] * gt[3]); w.z = pk_bf16(c[0] * gt[4], c[1] * gt[5]); w.w = pk_bf16(c[2] * gt[6], c[3] * gt[7]);
    *(u32x4*)(Y + grow * D + 256 + h * 64 + ch * 8) = w;
  }
  __syncthreads();
}

#define XB_TMO      128
#define XB_XCNT(j)  (256  + 64 * (j))
#define XB_XSUB(j)  (1280 + 64 * (j))
#define XB_XGEN(j)  (2304 + 64 * (j))
#define XB_TOP      3328
#define XB_TOPGEN   3392
#define XCD_BAR_WORDS 3456
#define XB_SPIN_CAP (1u << 18)
__device__ __forceinline__ unsigned xb_ld(unsigned* p)              { return __hip_atomic_load(p, __ATOMIC_RELAXED, __HIP_MEMORY_SCOPE_AGENT); }
__device__ __forceinline__ unsigned xb_add(unsigned* p, unsigned v) { return __hip_atomic_fetch_add(p, v, __ATOMIC_RELAXED, __HIP_MEMORY_SCOPE_AGENT); }
__device__ __forceinline__ unsigned xb_xcc_id() { return (unsigned)__builtin_amdgcn_s_getreg((3 << 11) | 20) & 0xFu; }
#define XB_SPIN(cond, bar) do { unsigned _sp = 0; while (cond) { __builtin_amdgcn_s_sleep(1); \
    if ((++_sp & 255u) == 0u) { if (xb_ld(&(bar)[XB_TMO])) break; if (_sp > XB_SPIN_CAP) { atomicAdd(&(bar)[XB_TMO], 1u); break; } } } } while (0)
struct XcdBarrier { unsigned* bar; unsigned x; volatile LAS unsigned* st; };
__device__ __forceinline__ XcdBarrier xcd_barrier_post(unsigned* bar, volatile LAS unsigned* st) {
  XcdBarrier b; b.bar = bar; b.x = xb_xcc_id(); b.st = st;
  if (threadIdx.x == 0) (void)xb_add(&bar[XB_XCNT(b.x)], 1u);
  return b;
}
__device__ __forceinline__ void xcd_barrier_complete(unsigned* bar, unsigned x, unsigned& nloc, unsigned& nx) {
  const unsigned G = gridDim.x * gridDim.y * gridDim.z;
  unsigned sum, cnt, mine, sp = 0u;
  for (;;) {
    sum = 0u; cnt = 0u; mine = 0u;
#pragma unroll
    for (unsigned j = 0; j < 16; ++j) { const unsigned c = xb_ld(&bar[XB_XCNT(j)]); sum += c; cnt += (c > 0u) ? 1u : 0u; mine = (j == x) ? c : mine; }
    if (sum == G) break;
    __builtin_amdgcn_s_sleep(1);
    if ((++sp & 255u) == 0u) { if (xb_ld(&bar[XB_TMO])) break; if (sp > XB_SPIN_CAP) { atomicAdd(&bar[XB_TMO], 1u); break; } }
  }
  nloc = mine > 0u ? mine : 1u; nx = cnt > 0u ? cnt : 1u;
}
__device__ __forceinline__ void xcd_barrier(const XcdBarrier& b_) {
  asm volatile("s_waitcnt vmcnt(0)" ::: "memory");
  __syncthreads();
  if (threadIdx.x == 0) {
    XcdBarrier b; b.bar = b_.bar; b.st = b_.st; b.x = (unsigned)__builtin_amdgcn_readfirstlane((int)xb_xcc_id());
    unsigned* bar = b.bar;
    __builtin_amdgcn_s_waitcnt(0);
    unsigned nloc = b.st[0], nx = b.st[1];
    if (nloc == 0u) { xcd_barrier_complete(bar, b.x, nloc, nx); b.st[0] = nloc; b.st[1] = nx; }
    const unsigned old = xb_add(&bar[XB_XSUB(b.x)], 1u);
    const unsigned gen = old / nloc;
    if (old + 1u == (gen + 1u) * nloc) {
      __builtin_amdgcn_fence(__ATOMIC_RELEASE, "agent");
      asm volatile("s_waitcnt vmcnt(0)" ::: "memory");
      const unsigned og = xb_add(&bar[XB_TOP], 1u);
      const unsigned tg = og / nx;
      if (og + 1u == (tg + 1u) * nx) xb_add(&bar[XB_TOPGEN], 1u);
      else XB_SPIN(xb_ld(&bar[XB_TOPGEN]) == tg, bar);
      __builtin_amdgcn_fence(__ATOMIC_ACQUIRE, "agent");
      xb_add(&bar[XB_XGEN(b.x)], 1u);
      asm volatile("s_waitcnt vmcnt(0)" ::: "memory");
    } else {
      XB_SPIN(xb_ld(&bar[XB_XGEN(b.x)]) == gen, bar);
      __builtin_amdgcn_fence(__ATOMIC_ACQUIRE, "agent");
      asm volatile("s_waitcnt vmcnt(0)" ::: "memory");
    }
  }
  __syncthreads();
}

__global__ void __launch_bounds__(512, 2) fwd(Params p) {
  extern __shared__ __attribute__((aligned(16))) unsigned char lds_raw[];
  cg::grid_group grid = cg::this_grid();
  LAS unsigned char* lds = (LAS unsigned char*)lds_raw;
  const int tid = threadIdx.x, lane = tid & 63, wid = __builtin_amdgcn_readfirstlane(tid >> 6);
  const int G = gridDim.x, bx = blockIdx.x;
  if (tid < 16) ((LAS unsigned*)(lds + MISC_OFF))[tid] = 0u;
  __syncthreads();
  (void)xcd_barrier_post((unsigned*)(p.ws + WS_CTL), (volatile LAS unsigned*)(lds + MISC_OFF) + 8);
#define PHASE_PTRS() size_t wso_ = 0; asm volatile("" : "+s"(wso_)); unsigned char* ws = p.ws + wso_;     \
  float* stats = (float*)(ws + WS_STATS); bf16_t* xb = (bf16_t*)(ws + WS_XB); bf16_t* proj = (bf16_t*)(ws + WS_R); \
  bf16_t* Pbuf = (bf16_t*)(ws + WS_R); bf16_t* Yb = (bf16_t*)(ws + WS_Y); bf16_t* mrg = (bf16_t*)(ws + WS_MRG); const float* st_l = stats + (size_t)l * M * SROW; \
  (void)stats; (void)xb; (void)proj; (void)Pbuf; (void)Yb; (void)mrg; (void)st_l

#ifndef PH_MASK
#define PH_MASK 0xFF
#endif
#ifndef DUP_PHASE
#define DUP_PHASE 0
#endif
#define GSYNC() do { XcdBarrier xb_; xb_.bar = (unsigned*)(p.ws + WS_CTL); xb_.x = 0; xb_.st = (volatile LAS unsigned*)(lds + MISC_OFF) + 8; xcd_barrier(xb_); if (DUP_PHASE == 5) xcd_barrier(xb_); } while (0)
#define REP(k) _Pragma("unroll 1") for (int rep_ = 0; rep_ < ((DUP_PHASE == (k)) ? 2 : 1); ++rep_)
  REP(1) if constexpr (PH_MASK & 1) p0_prologue(p, lds, tid, lane, wid, G, bx);
  if (p.ws == nullptr) grid.sync();
  GSYNC();

  for (int l = 0; l < 2; ++l) {
    REP(2) if constexpr (PH_MASK & 2) {
      PHASE_PTRS();
      pg8::Gemm g{xb, (const bf16_t*)(ws + WS_W1T) + (size_t)l * NP * D, D, D, D};
      pg8::SchedGrid S; S.init(M, NP, G, bx, D, D);
      pg8::Epi1 E{proj, pg8::RstdLds{st_l, lds}};
      pg8::gemm_phase<pg8::Epi1, pg8::SchedGrid, true>(lds, g, S, E);
    }
    GSYNC();
    REP(3) {
      for (int v = bx; v < 256; v += G) {
        PHASE_PTRS();
        const int bh = (v & 7) * 4 + (v >> 6), s = (v >> 3) & 7; const int b = bh >> 2, h = bh & 3; const float fb = p.f_bias[l * 4 + h];
        if constexpr (PH_MASK & 32) { attn_unit(lds, proj, Yb, st_l, fb, b, h, 15 - s, opaque_v(tid), true);
        attn_unit(lds, proj, Yb, st_l, fb, b, h, s, opaque_v(tid), false); }
      }
      {
        unsigned* qctr = (unsigned*)(p.ws + WS_CTL + 14336) + (l * 2 + rep_) * 16;
        volatile LAS unsigned* qw = (volatile LAS unsigned*)(lds + MISC_OFF) + 12;
#pragma unroll 1
        for (;;) {
          if (tid == 0) qw[0] = __hip_atomic_fetch_add(qctr, 1u, __ATOMIC_RELAXED, __HIP_MEMORY_SCOPE_AGENT);
          __syncthreads();
          const int item = (int)qw[0];
          __syncthreads();
          constexpr int WQ = (I_L + 7) / 8;
          if (item >= 768 + (l == 0 ? WQ : 0)) break;
          if (item >= 768) { const int r = (item - 768) * 8 + wid; if (r < I_L) weight_item(p, 1, r, (LAS float*)(lds + wid * 16384), opaque_v(tid) & 63); __syncthreads(); continue; }
          PHASE_PTRS();
          const int m0 = (item / 3) * 128, kind = item % 3;
          int z = 0; asm volatile("" : "+s"(z));
          if (kind < 2) {
            if constexpr (PH_MASK & 4) conv_c(proj, Yb, p.short_conv_w + l * 3 * 256 + z, m0, opaque_v(tid), 4 * kind);
            asm volatile("" : "+s"(z));
            if constexpr (PH_MASK & 8) conv_d(lds, proj, Yb, p.conf_dw_w + l * 31 * 256 + z, p.conf_dw_b + l * 256 + z, p.conf_ln_g + l * 256 + z, p.conf_ln_b + l * 256 + z, m0, opaque_v(tid), 2 * kind);
          } else {
            if constexpr (PH_MASK & 16) gmlp_unit(lds, proj, Yb, (const bf16_t*)(ws + WS_SGUW) + (size_t)l * 4 * 128 * 128 + z, p.sgu_b + l * 4 * 128 + z, p.sgu_ln_g + l * 256 + z, p.sgu_ln_b + l * 256 + z, m0, opaque_v(tid));
          }
          asm volatile("" : "+s"(z));
          __syncthreads();
        }
      }
    }
    GSYNC();
    REP(4) if constexpr (PH_MASK & 64) for (int vc = bx; vc < 256; vc += G) {
      PHASE_PTRS();
      REP(7) {
        pg8::Gemm g{Yb, (const bf16_t*)(ws + WS_WBT) + (size_t)l * 4 * D * 256, D, 256, 256};
        pg8::SchedPB S{vc}; pg8::Epi3a E{Pbuf};
#ifndef NO3A
        pg8::gemm_phase<pg8::Epi3a, pg8::SchedPB, true>(lds, g, S, E);
#endif
      }
      __builtin_amdgcn_fence(__ATOMIC_RELEASE, "workgroup"); __syncthreads(); __builtin_amdgcn_fence(__ATOMIC_ACQUIRE, "workgroup");
      {
        pg8::Gemm g{xb, (const bf16_t*)(ws + WS_WMT) + (size_t)l * 4096 * D, D, D, D};
        pg8::SchedL S{vc}; pg8::Epi3b E{Pbuf, mrg, pg8::RstdLds{st_l, lds}};
#ifndef NO3B
        pg8::gemm_phase<pg8::Epi3b, pg8::SchedL, true>(lds, g, S, E);
#endif
      }
    }
    GSYNC();
    if constexpr (PH_MASK & 128) {
      PHASE_PTRS();
      pg8::Gemm g{mrg, (const bf16_t*)(ws + WS_WOT) + (size_t)l * D * D, D, D, D};
      pg8::SchedGrid S; S.init(M, D, G, bx, D, D);
      float* st_n = stats + (size_t)(l + 1) * M * SROW;
      if (l == 0) { pg8::Epi4<true> E{p.x, nullptr, xb, st_n, (const float*)(ws + WS_WF) + D * 4, lds}; pg8::gemm_phase<pg8::Epi4<true>, pg8::SchedGrid, true>(lds, g, S, E); }
      else        { pg8::Epi4<false> E{nullptr, xb, Yb, st_n, nullptr, lds}; pg8::gemm_phase<pg8::Epi4<false>, pg8::SchedGrid, true>(lds, g, S, E); }
    }
    GSYNC();
  }
  {
    const int l = 2; PHASE_PTRS();
    const int lane = opaque_v(tid) & 63;
    const float* st = st_l;
    f32x4 gv[4];
#pragma unroll
    for (int j = 0; j < 4; ++j) gv[j] = *((const f32x4*)p.final_g + 64 * j + lane);
    for (int m = bx * 8 + wid; m < M; m += G * 8) {
      const float rs = row_rstd(st + (size_t)m * SROW);
      f32x4* xr = (f32x4*)(p.out + (size_t)m * D) + lane; const u32x2* xs = (const u32x2*)(Yb + (size_t)m * D) + lane;
#pragma unroll
      for (int j = 0; j < 4; ++j) { const u32x2 w = __builtin_nontemporal_load(&xs[64 * j]); const f32x4 v = {bf_lo(w.x), bf_hi(w.x), bf_lo(w.y), bf_hi(w.y)}; __builtin_nontemporal_store(v * rs * gv[j], &xr[64 * j]); }
    }
  }
}

extern "C" void kernel_launch(void* const* d_in, const int* in_sizes, int n_in, void* d_out, int out_size, void* d_ws, size_t ws_size, hipStream_t stream) {
  static int grid_blocks = 0;
  if (!grid_blocks) {
    int dev = 0, cus = 0, per_cu = 0;
    (void)hipGetDevice(&dev);
    (void)hipDeviceGetAttribute(&cus, hipDeviceAttributeMultiprocessorCount, dev);
    (void)hipFuncSetAttribute((const void*)fwd, hipFuncAttributeMaxDynamicSharedMemorySize, LDS_BYTES);
    (void)hipOccupancyMaxActiveBlocksPerMultiprocessor(&per_cu, (const void*)fwd, 512, LDS_BYTES);
    if (per_cu < 1) per_cu = 1;
    grid_blocks = cus * per_cu;
    if (grid_blocks > 256) grid_blocks = 256;
    if (ws_size < WS_END || n_in != 16 || out_size != M * D) fprintf(stderr, "kernel_launch: unexpected sizes: ws %zu (need %zu), n_in %d, out %d\n", ws_size, (size_t)WS_END, n_in, out_size);
  }
  (void)hipMemsetAsync((char*)d_ws + WS_CTL, 0, CTL_BYTES, stream);
  Params p{};
  p.x = (const float*)d_in[0]; p.norm_g = (const float*)d_in[1]; p.w_in = (const float*)d_in[2]; p.f_bias = (const float*)d_in[3]; p.sgu_w = (const float*)d_in[4];
  p.sgu_b = (const float*)d_in[5]; p.sgu_ln_g = (const float*)d_in[6]; p.sgu_ln_b = (const float*)d_in[7]; p.short_conv_w = (const float*)d_in[8]; p.conf_dw_w = (const float*)d_in[9];
  p.conf_dw_b = (const float*)d_in[10]; p.conf_ln_g = (const float*)d_in[11]; p.conf_ln_b = (const float*)d_in[12]; p.w_branch = (const float*)d_in[13]; p.w_out = (const float*)d_in[14];
  p.final_g = (const float*)d_in[15]; p.out = (float*)d_out; p.ws = (unsigned char*)d_ws;
  void* args[] = {&p};
  hipError_t e = hipLaunchCooperativeKernel((void*)fwd, dim3(grid_blocks), dim3(512), args, LDS_BYTES, stream);
  if (e != hipSuccess) fprintf(stderr, "cooperative launch failed: %s (grid %d)\n", hipGetErrorString(e), grid_blocks);
}
```

```cpp
#include <hip/hip_runtime.h>
#include <hip/hip_cooperative_groups.h>
#include <cstdio>
#include <cstdint>
namespace cg = cooperative_groups;

#define LAS __attribute__((address_space(3)))
#define GAS __attribute__((address_space(1)))
typedef unsigned short bf16_t;
typedef short bf16x8 __attribute__((ext_vector_type(8)));
typedef short s16x4 __attribute__((ext_vector_type(4)));
typedef float f32x2 __attribute__((ext_vector_type(2)));
typedef float f32x4 __attribute__((ext_vector_type(4)));
typedef float f32x16 __attribute__((ext_vector_type(16)));
typedef unsigned u32x2 __attribute__((ext_vector_type(2)));
typedef unsigned u32x4 __attribute__((ext_vector_type(4)));
typedef __bf16 bf16x2_t __attribute__((ext_vector_type(2)));

constexpr int M = 32768, D = 1024, SEQ = 4096, NP = 3584, INC = 7684, NHEAD = 4;
constexpr float EPS = 1e-6f;
constexpr float LOG2E = 1.4426950408889634f;
constexpr float C2 = 0.125f * LOG2E;
constexpr int PC_U = 0, PC_V = 256, PC_AG = 512, PC_Q = 768, PC_K = 1024, PC_VV = 1280, PC_BG = 1536, PC_CB = 1792, PC_CC = 2048, PC_CX = 2304, PC_CG = 2560,
              PC_DA = 2816, PC_DS = 3072, PC_DG = 3328;
constexpr size_t MiB = 1u << 20;
constexpr size_t WS_STATS = 490 * MiB, WS_WF = 3 * MiB, WS_SGUW = 3 * MiB + 512 * 1024, WS_W1T = 4 * MiB, WS_WMT = 18 * MiB, WS_WBT = 34 * MiB, WS_WOT = 38 * MiB,
                 WS_XB = 42 * MiB, WS_R = 106 * MiB, WS_Y = 362 * MiB, WS_MRG = 426 * MiB, WS_END = 502 * MiB;
constexpr int SROW = 32;
constexpr size_t WS_CTL = 3 * MiB + 128 * 1024, CTL_BYTES = 16384;
constexpr int LDS_BYTES = 147456, MISC_OFF = 131072 + 320;

__device__ __forceinline__ unsigned pk_bf16(float lo, float hi) { f32x2 v = {lo, hi}; bf16x2_t b = __builtin_convertvector(v, bf16x2_t); return __builtin_bit_cast(unsigned, b); }
__device__ __forceinline__ float bf_lo(unsigned u) { return __uint_as_float(u << 16); }
__device__ __forceinline__ float bf_hi(unsigned u) { return __uint_as_float(u & 0xffff0000u); }
__device__ __forceinline__ void unpack8(const u32x4 v, float* f) {
  f[0] = bf_lo(v.x); f[1] = bf_hi(v.x); f[2] = bf_lo(v.y); f[3] = bf_hi(v.y); f[4] = bf_lo(v.z); f[5] = bf_hi(v.z); f[6] = bf_lo(v.w); f[7] = bf_hi(v.w);
}
__device__ __forceinline__ int opaque_v(int v) { asm volatile("" : "+v"(v)); return v; }
__device__ __forceinline__ float fast_sigmoid(float z) { return __builtin_amdgcn_rcpf(1.0f + __builtin_amdgcn_exp2f(-LOG2E * z)); }
__device__ __forceinline__ float act_apply(int act, float v) {
  if (act == 1) { const float u = 1.5957691216057308f * (v + 0.044715f * v * v * v); return v * fast_sigmoid(u); }
  if (act == 2) return v * fast_sigmoid(v);
  if (act == 3) return fast_sigmoid(v);
  if (act == 4) return v * C2;
  return v;
}

__device__ __forceinline__ float row_sumsq(const float* st_row) { return (st_row[0] + st_row[8]) + (st_row[16] + st_row[24]); }
__device__ __forceinline__ float row_rstd(const float* st_row) { return rsqrtf(row_sumsq(st_row) * (1.0f / D) + EPS); }

namespace pg8 {
#ifndef WGM_SEL
#define WGM_SEL 4
#endif
constexpr int BM = 256, BK = 64, HALF = 128, HTB = HALF * BK * 2, STAGE_BYTES = 8 * HTB, NXCD = 8, WGM = WGM_SEL;
__host__ __device__ __forceinline__ int lds_byte(int r, int c) { const int st = (r >> 4) * 2 + (c >> 5), rr = r & 15, cc = c & 31, ob = rr * 64 + cc * 2; return st * 1024 + (ob ^ (((ob >> 9) & 1) << 5)); }
__host__ __device__ __forceinline__ void stage_rc(int b, int& R, int& C) { const int st = b / 1024, sb = b % 1024, swz = sb ^ (((sb >> 9) & 1) << 5); R = (st >> 1) * 16 + swz / 64; C = (st & 1) * 32 + (swz % 64) / 2; }
__host__ __device__ __forceinline__ int perm32(int rho) { const int n = rho >> 4, i = rho & 15; return 8 * (i >> 2) + 4 * n + (i & 3); }

struct Unit { int pm, pn, z; size_t a_byte, b_byte; };
struct Gemm { const bf16_t* A; const bf16_t* Bt; int lda, ldb, K; };

struct SchedGrid {
  int nM, nN, nwg, G, c; size_t astep, bstep;
  __device__ void init(int Mr, int N, int G_, int c_, int lda, int ldb) { nM = Mr / BM; nN = N / BM; nwg = nM * nN; G = G_; c = c_; astep = (size_t)BM * lda * 2; bstep = (size_t)BM * ldb * 2; }
  __device__ bool next(int i, Unit& u) const {
    const long L = (long)i * G + c; if (L >= nwg) return false;
    int wgid = (int)L; { const int q = nwg / NXCD, r = nwg % NXCD, xcd = wgid % NXCD, off = wgid / NXCD; wgid = (xcd < r ? xcd * (q + 1) : r * (q + 1) + (xcd - r) * q) + off; }
    const int nig = WGM * nN, gid = wgid / nig, fm = gid * WGM, gsz = (nM - fm) < WGM ? (nM - fm) : WGM;
    u.pm = fm + ((wgid % nig) % gsz); u.pn = (wgid % nig) / gsz; u.z = 0; u.a_byte = (size_t)u.pm * astep; u.b_byte = (size_t)u.pn * bstep; return true;
  }
};
struct SchedPB {
  int vc;
  __device__ bool next(int i, Unit& u) const {
    if (i >= 8) return false; const int xq = vc & 7, jq = vc >> 3; const int pm = xq * 16 + (jq >> 1), pn = 2 * (jq & 1) + (i & 1), n = i >> 1;
    u.pm = pm; u.pn = pn; u.z = n; u.a_byte = ((size_t)pm * 256 * 1024 + (size_t)n * 256) * 2; u.b_byte = ((size_t)(n * 1024 + pn * 256) * 256) * 2; return true;
  }
};
struct SchedL {
  int vc;
  __device__ bool next(int i, Unit& u) const {
    if (i >= 8) return false; const int xq = vc & 7, jq = vc >> 3; const int pm = xq * 16 + (jq >> 1), pn = 8 * (jq & 1) + i;
    u.pm = pm; u.pn = pn; u.z = 0; u.a_byte = (size_t)pm * 256 * 1024 * 2; u.b_byte = (size_t)pn * 256 * 1024 * 2; return true;
  }
};

constexpr int RSTD_OFF = STAGE_BYTES + 6144;
struct RstdLds {
  const float* stats; LAS unsigned char* lds;
  __device__ __forceinline__ void request(const Unit* nx, int tid, float (&q)[4]) const {
    if (nx && tid < 256) { const GAS float* st = (const GAS float*)stats + (size_t)(nx->pm * BM + tid) * SROW; q[0] = st[0]; q[1] = st[8]; q[2] = st[16]; q[3] = st[24]; }
  }
  __device__ __forceinline__ void park(const Unit* nx, int par_next, int tid, const float (&q)[4]) const {
    if (nx && tid < 256) ((LAS float*)(lds + RSTD_OFF))[par_next * 256 + tid] = rsqrtf(((q[0] + q[1]) + (q[2] + q[3])) * (1.0f / D) + EPS);
  }
  __device__ __forceinline__ void prime(const Unit& u, int par, int tid) const {
    if (tid < 256) { const GAS float* st = (const GAS float*)stats + (size_t)(u.pm * BM + tid) * SROW; ((LAS float*)(lds + RSTD_OFF))[par * 256 + tid] = rsqrtf(((st[0] + st[8]) + (st[16] + st[24])) * (1.0f / D) + EPS); }
  }
  __device__ __forceinline__ float get(int par, int rl) const { return ((const LAS float*)(lds + RSTD_OFF))[par * 256 + rl]; }
};
struct Epi1 {
  static constexpr bool PERM = true;
  bf16_t* O; RstdLds R;
  __device__ __forceinline__ void pre(const Unit& u, int par, int tid) const { R.prime(u, par, tid); }
  __device__ __forceinline__ void operator()(const f32x4 (&acc)[2][2][4][2], const Unit& u, int wr, int wc, int fr, int fq, int par, bool has_nx, const Unit& nx) const {
    const int tid_ = (wr * 4 + wc) * 64 + fq * 16 + fr;
    const int pn = u.pn;
    const int act = (pn <= 1) ? 1 : (pn == 2 || pn == 6 || pn == 10 || pn == 13) ? 2 : (pn == 12) ? 3 : (pn == 3) ? 4 : 0;
    const int row0 = u.pm * BM + wr * 64 + fr; const int col0 = pn * BM + wc * 32 + 8 * fq;
#pragma unroll
    for (int ai = 0; ai < 2; ++ai)
#pragma unroll
      for (int m = 0; m < 4; ++m) {
        const int row = row0 + ai * HALF + m * 16;
        const float rs = R.get(par, ai * HALF + wr * 64 + m * 16 + fr);
        bf16_t* rowp = O + (size_t)row * NP + col0;
#pragma unroll
        for (int bj = 0; bj < 2; ++bj) {
          f32x4 v0 = acc[ai][bj][m][0] * rs, v1 = acc[ai][bj][m][1] * rs;
          if (act != 0) {
#pragma unroll
            for (int j = 0; j < 4; ++j) { v0[j] = act_apply(act, v0[j]); v1[j] = act_apply(act, v1[j]); }
          }
          u32x4 w; w.x = pk_bf16(v0[0], v0[1]); w.y = pk_bf16(v0[2], v0[3]); w.z = pk_bf16(v1[0], v1[1]); w.w = pk_bf16(v1[2], v1[3]);
          __builtin_nontemporal_store(w, (u32x4*)(rowp + bj * HALF));
        }
      }
    if (has_nx) R.prime(nx, par ^ 1, tid_);
  }
};
struct Epi3a {
  static constexpr bool PERM = true;
  bf16_t* O;
  __device__ __forceinline__ void pre(const Unit&, int, int) const {}
  __device__ __forceinline__ void operator()(const f32x4 (&acc)[2][2][4][2], const Unit& u, int wr, int wc, int fr, int fq, int, bool, const Unit&) const {
    const int row0 = u.pm * BM + wr * 64 + fr; const int col0 = u.z * 1024 + u.pn * BM + wc * 32 + 8 * fq;
#pragma unroll
    for (int ai = 0; ai < 2; ++ai)
#pragma unroll
      for (int m = 0; m < 4; ++m) {
        bf16_t* rowp = O + (size_t)(row0 + ai * HALF + m * 16) * 4096 + col0;
#pragma unroll
        for (int bj = 0; bj < 2; ++bj) {
          const f32x4 v0 = acc[ai][bj][m][0], v1 = acc[ai][bj][m][1];
          u32x4 w; w.x = pk_bf16(v0[0], v0[1]); w.y = pk_bf16(v0[2], v0[3]); w.z = pk_bf16(v1[0], v1[1]); w.w = pk_bf16(v1[2], v1[3]);
          *(u32x4*)(rowp + bj * HALF) = w;
        }
      }
  }
};
struct Epi3b {
  static constexpr bool PERM = false;
  const bf16_t* P; bf16_t* O; RstdLds R;
  __device__ __forceinline__ void pre(const Unit& u, int par, int tid) const { R.prime(u, par, tid); }
  __device__ __forceinline__ void operator()(const f32x4 (&acc)[2][2][4][2], const Unit& u, int wr, int wc, int fr, int fq, int par, bool has_nx, const Unit& nx) const {
    const int tid_ = (wr * 4 + wc) * 64 + fq * 16 + fr;
    const int row0 = u.pm * BM + wr * 64 + fr; const int d0 = u.pn * 64 + wc * 16 + 4 * fq;
    u32x2 np[4];
#define E3_LOAD(g_) do { const GAS bf16_t* pr_ = (const GAS bf16_t*)P + (size_t)(row0 + ((g_) >> 2) * HALF + ((g_) & 3) * 16) * 4096 + d0; \
      _Pragma("unroll") for (int br_ = 0; br_ < 4; ++br_) np[br_] = *(const GAS u32x2*)(pr_ + br_ * 1024); } while (0)
    E3_LOAD(0);
#pragma unroll
    for (int ai = 0; ai < 2; ++ai)
#pragma unroll
      for (int m = 0; m < 4; ++m) {
        const int row = row0 + ai * HALF + m * 16;
        const float rsn = -LOG2E * R.get(par, ai * HALF + wr * 64 + m * 16 + fr);
        u32x2 cp[4];
#pragma unroll
        for (int br = 0; br < 4; ++br) cp[br] = np[br];
        if (ai * 4 + m + 1 < 8) E3_LOAD(ai * 4 + m + 1);
        f32x4 sum = {0.f, 0.f, 0.f, 0.f};
#pragma unroll
        for (int bj = 0; bj < 2; ++bj)
#pragma unroll
          for (int n = 0; n < 2; ++n) {
            const u32x2 pv = cp[2 * bj + n];
            const f32x4 a = acc[ai][bj][m][n] * rsn;
            sum[0] += __builtin_amdgcn_rcpf(1.0f + __builtin_amdgcn_exp2f(a[0])) * bf_lo(pv.x); sum[1] += __builtin_amdgcn_rcpf(1.0f + __builtin_amdgcn_exp2f(a[1])) * bf_hi(pv.x);
            sum[2] += __builtin_amdgcn_rcpf(1.0f + __builtin_amdgcn_exp2f(a[2])) * bf_lo(pv.y); sum[3] += __builtin_amdgcn_rcpf(1.0f + __builtin_amdgcn_exp2f(a[3])) * bf_hi(pv.y);
          }
        u32x2 w; w.x = pk_bf16(sum[0], sum[1]); w.y = pk_bf16(sum[2], sum[3]);
        *(u32x2*)(O + (size_t)row * 1024 + d0) = w;
      }
#undef E3_LOAD
    if (has_nx) R.prime(nx, par ^ 1, tid_);
  }
};
template <bool WITH_NEXT> struct Epi4 {
  static constexpr bool PERM = true;
  const float* base; const bf16_t* baseb; bf16_t* xb; float* stn; const float* wf; LAS unsigned char* lds;
  __device__ __forceinline__ void pre(const Unit&, int, int) const {}
  __device__ __forceinline__ void operator()(const f32x4 (&acc)[2][2][4][2], const Unit& u, int wr, int wc, int fr, int fq, int, bool, const Unit&) const {
    LAS float* redF = (LAS float*)(lds + 3 * HTB);
    LAS float* redS = (LAS float*)(lds + STAGE_BYTES + 1024);
    const int row0 = u.pm * BM + wr * 64 + fr; const int col0 = u.pn * BM + wc * 32 + 8 * fq;
    constexpr int RD = WITH_NEXT ? 1 : 4;
    u32x4 ring[RD][WITH_NEXT ? 4 : 2];
#define E4_LOAD(g_) do { const int row_ = row0 + ((g_) >> 2) * HALF + ((g_) & 3) * 16; const size_t off_ = (size_t)row_ * D + col0; \
      _Pragma("unroll") for (int bj_ = 0; bj_ < 2; ++bj_) { \
        if constexpr (WITH_NEXT) { ring[0][2 * bj_] = __builtin_nontemporal_load((const u32x4*)(base + off_ + bj_ * HALF)); ring[0][2 * bj_ + 1] = __builtin_nontemporal_load((const u32x4*)(base + off_ + bj_ * HALF + 4)); } \
        else ring[(g_) % RD][bj_] = __builtin_nontemporal_load((const u32x4*)(baseb + off_ + bj_ * HALF)); } } while (0)
#pragma unroll
    for (int g0 = 0; g0 < RD; ++g0) E4_LOAD(g0);
#pragma unroll
    for (int ai = 0; ai < 2; ++ai)
#pragma unroll
      for (int m = 0; m < 4; ++m) {
        const int row = row0 + ai * HALF + m * 16; const size_t off = (size_t)row * D + col0;
        float ss = 0.f, f0 = 0.f, f1 = 0.f, f2 = 0.f, f3 = 0.f;
        f32x4 cb[4];
        if constexpr (WITH_NEXT) {
#pragma unroll
          for (int q = 0; q < 4; ++q) cb[q] = __builtin_bit_cast(f32x4, ring[0][q]);
        } else {
#pragma unroll
          for (int bj = 0; bj < 2; ++bj) { const u32x4 w_ = ring[(ai * 4 + m) % RD][bj]; cb[2 * bj] = (f32x4){bf_lo(w_.x), bf_hi(w_.x), bf_lo(w_.y), bf_hi(w_.y)}; cb[2 * bj + 1] = (f32x4){bf_lo(w_.z), bf_hi(w_.z), bf_lo(w_.w), bf_hi(w_.w)}; }
        }
        if (ai * 4 + m + RD < 8) E4_LOAD(ai * 4 + m + RD);
#pragma unroll
        for (int bj = 0; bj < 2; ++bj) {
          const f32x4 x0 = cb[2 * bj] + acc[ai][bj][m][0], x1 = cb[2 * bj + 1] + acc[ai][bj][m][1];
          ss += ((x0[0] * x0[0] + x0[1] * x0[1]) + (x0[2] * x0[2] + x0[3] * x0[3])) + ((x1[0] * x1[0] + x1[1] * x1[1]) + (x1[2] * x1[2] + x1[3] * x1[3]));
          { u32x4 w; w.x = pk_bf16(x0[0], x0[1]); w.y = pk_bf16(x0[2], x0[3]); w.z = pk_bf16(x1[0], x1[1]); w.w = pk_bf16(x1[2], x1[3]); *(u32x4*)(xb + off + bj * HALF) = w; }
          if (WITH_NEXT) {
#pragma unroll
            for (int j = 0; j < 4; ++j) { const f32x4 wv = *(const f32x4*)(wf + (size_t)(col0 + bj * HALF + j) * 4); f0 += x0[j] * wv[0]; f1 += x0[j] * wv[1]; f2 += x0[j] * wv[2]; f3 += x0[j] * wv[3]; }
#pragma unroll
            for (int j = 0; j < 4; ++j) { const f32x4 wv = *(const f32x4*)(wf + (size_t)(col0 + bj * HALF + 4 + j) * 4); f0 += x1[j] * wv[0]; f1 += x1[j] * wv[1]; f2 += x1[j] * wv[2]; f3 += x1[j] * wv[3]; }
          }
        }
        ss += __shfl_xor(ss, 16); ss += __shfl_xor(ss, 32);
        if (WITH_NEXT) { f0 += __shfl_xor(f0, 16); f0 += __shfl_xor(f0, 32); f1 += __shfl_xor(f1, 16); f1 += __shfl_xor(f1, 32);
                         f2 += __shfl_xor(f2, 16); f2 += __shfl_xor(f2, 32); f3 += __shfl_xor(f3, 16); f3 += __shfl_xor(f3, 32); }
        if (fq == 0) {
          const int rl = ai * HALF + wr * 64 + m * 16 + fr;
          redS[wc * 256 + rl] = ss;
          if (WITH_NEXT) { redF[(0 * 4 + wc) * 256 + rl] = f0; redF[(1 * 4 + wc) * 256 + rl] = f1; redF[(2 * 4 + wc) * 256 + rl] = f2; redF[(3 * 4 + wc) * 256 + rl] = f3; }
        }
      }
#undef E4_LOAD
    asm volatile("s_waitcnt lgkmcnt(0)" ::: "memory"); __builtin_amdgcn_s_barrier(); asm volatile("" ::: "memory");
    {
      const int t = (wr * 4 + wc) * 64 + fq * 16 + fr; const int rl = t & 255, part = t >> 8;
      float* dst = stn + ((size_t)(u.pm * BM + rl) * 4 + u.pn) * 8;
      if (part == 0) {
        dst[0] = (redS[rl] + redS[256 + rl]) + (redS[512 + rl] + redS[768 + rl]);
        if (WITH_NEXT) { dst[1] = (redF[rl] + redF[256 + rl]) + (redF[512 + rl] + redF[768 + rl]);
                         dst[2] = (redF[1024 + rl] + redF[1280 + rl]) + (redF[1536 + rl] + redF[1792 + rl]); }
      } else if (WITH_NEXT) {
        dst[3] = (redF[2048 + rl] + redF[2304 + rl]) + (redF[2560 + rl] + redF[2816 + rl]);
        dst[4] = (redF[3072 + rl] + redF[3328 + rl]) + (redF[3584 + rl] + redF[3840 + rl]);
      }
    }
    asm volatile("s_waitcnt lgkmcnt(0)" ::: "memory"); __builtin_amdgcn_s_barrier(); asm volatile("" ::: "memory");
  }
};

template <class Epi, class Sched, bool ALIGN_EPI = true>
__device__ __forceinline__ void gemm_phase(LAS unsigned char* lds, const Gemm g, const Sched& S, const Epi& E) {
  const int tid = opaque_v((int)threadIdx.x), wid = __builtin_amdgcn_readfirstlane(tid >> 6), lane = tid & 63, wr = wid >> 2, wc = wid & 3, fr = lane & 15, fq = lane >> 4;
  const int K = g.K, nt = K / BK;
  unsigned voffA[2], voffB[2];
#pragma unroll
  for (int i = 0; i < 2; ++i) { int R, C; stage_rc(tid * 16 + i * 8192, R, C); const int Rb = Epi::PERM ? ((R & ~31) + perm32(R & 31)) : R;
    voffA[i] = (unsigned)(R * g.lda + C) * 2u; voffB[i] = (unsigned)(Rb * g.ldb + C) * 2u; }
  const size_t kstep = (size_t)(BK * 2);
  const size_t hstepA = (size_t)HALF * g.lda * 2, hstepB = (size_t)HALF * g.ldb * 2;
  const unsigned ldsw = (unsigned)wid * 1024u;
  const int aoff = lds_byte(wr * 64 + fr, fq * 8), boff = lds_byte(wc * 32 + fr, fq * 8);
#define PG8_SA(b, h) (((b) * 2 + (h)) * HTB)
#define PG8_SB(b, h) ((4 + (b) * 2 + (h)) * HTB)
#define PG8_STAGE(bufoff, gbase, voff) do { _Pragma("unroll") for (int _i = 0; _i < 2; ++_i) \
    __builtin_amdgcn_global_load_lds((const unsigned*)((const char*)(gbase) + (voff)[_i]), (LAS unsigned*)(lds + (bufoff) + ldsw + _i * 8192), 16, 0, 0); } while (0)
#define PG8_LDA(dst, b, h) do { _Pragma("unroll") for (int m = 0; m < 4; ++m) _Pragma("unroll") for (int k = 0; k < 2; ++k) dst[m][k] = *(const LAS bf16x8*)(lds + PG8_SA(b, h) + aoff + m * 2048 + k * 1024); } while (0)
#define PG8_LDB(dst, b, h) do { _Pragma("unroll") for (int n = 0; n < 2; ++n) _Pragma("unroll") for (int k = 0; k < 2; ++k) dst[n][k] = *(const LAS bf16x8*)(lds + PG8_SB(b, h) + boff + n * 2048 + k * 1024); } while (0)
#define PG8_MMA(ai, bj, At, Bt) do { __builtin_amdgcn_s_setprio(1); _Pragma("unroll") for (int m = 0; m < 4; ++m) _Pragma("unroll") for (int n = 0; n < 2; ++n) _Pragma("unroll") for (int k = 0; k < 2; ++k) \
    acc[ai][bj][m][n] = __builtin_amdgcn_mfma_f32_16x16x32_bf16(Bt[n][k], At[m][k], acc[ai][bj][m][n], 0, 0, 0); __builtin_amdgcn_s_setprio(0); } while (0)
#define PG8_WAIT_V(n) asm volatile("s_waitcnt vmcnt(" #n ")" ::: "memory")
#define PG8_WAIT_L(n) asm volatile("s_waitcnt lgkmcnt(" #n ")" ::: "memory")
#define PG8_BAR __builtin_amdgcn_s_barrier()
#define PG8_SCHED __builtin_amdgcn_sched_barrier(0)
  Unit cur, nxt; int ui = 0;
  if (!S.next(0, cur)) return;
  E.pre(cur, 0, tid);
  f32x4 acc[2][2][4][2];
#pragma unroll
  for (int a = 0; a < 2; ++a)
#pragma unroll
    for (int b = 0; b < 2; ++b)
#pragma unroll
      for (int m = 0; m < 4; ++m)
#pragma unroll
        for (int n = 0; n < 2; ++n) acc[a][b][m][n] = (f32x4){0.f, 0.f, 0.f, 0.f};
  bf16x8 At[4][2], B0[2][2], B1[2][2];
  const char* cA = (const char*)g.A + cur.a_byte; const char* cB = (const char*)g.Bt + cur.b_byte;
  PG8_STAGE(PG8_SB(0, 0), cB, voffB); PG8_STAGE(PG8_SB(0, 1), cB + hstepB, voffB); PG8_STAGE(PG8_SA(0, 0), cA, voffA); PG8_STAGE(PG8_SA(0, 1), cA + hstepA, voffA);
  if (wr == 1) PG8_BAR;
  PG8_WAIT_V(2); PG8_BAR;
  PG8_STAGE(PG8_SB(1, 0), cB + kstep, voffB); PG8_STAGE(PG8_SA(1, 0), cA + kstep, voffA); PG8_STAGE(PG8_SB(1, 1), cB + hstepB + kstep, voffB);
  PG8_WAIT_V(6); PG8_BAR;
  for (;;) {
    const bool has_next = S.next(ui + 1, nxt);
    const char* nA = has_next ? (const char*)g.A + nxt.a_byte : cA; const char* nB = has_next ? (const char*)g.Bt + nxt.b_byte : cB;
#pragma unroll 1
    for (int t = 0; t < nt; t += 2) {
      const bool last = (t == nt - 2);
      const char* a1 = cA + (size_t)(t + 1) * kstep;
      const char* a2 = last ? nA : cA + (size_t)(t + 2) * kstep; const char* b2 = last ? nB : cB + (size_t)(t + 2) * kstep;
      const char* a3 = a2 + kstep; const char* b3 = b2 + kstep;
      PG8_LDB(B0, 0, 0); PG8_LDB(B1, 0, 1); PG8_SCHED; PG8_LDA(At, 0, 0); PG8_STAGE(PG8_SA(1, 1), a1 + hstepA, voffA);
      PG8_WAIT_V(8); PG8_WAIT_L(0); PG8_BAR; PG8_MMA(0, 0, At, B0); PG8_MMA(0, 1, At, B1); PG8_BAR; PG8_SCHED;
      PG8_LDA(At, 0, 1); PG8_STAGE(PG8_SB(0, 0), b2, voffB); PG8_STAGE(PG8_SB(0, 1), b2 + hstepB, voffB); PG8_STAGE(PG8_SA(0, 0), a2, voffA);
      PG8_WAIT_V(8); PG8_WAIT_L(0); PG8_BAR; PG8_MMA(1, 0, At, B0); PG8_MMA(1, 1, At, B1); PG8_BAR; PG8_SCHED;
      PG8_LDB(B0, 1, 0); PG8_LDB(B1, 1, 1); PG8_SCHED; PG8_LDA(At, 1, 0); PG8_STAGE(PG8_SA(0, 1), a2 + hstepA, voffA);
      PG8_WAIT_V(8); PG8_WAIT_L(0); PG8_BAR; PG8_MMA(0, 0, At, B0); PG8_MMA(0, 1, At, B1); PG8_BAR; PG8_SCHED;
      PG8_LDA(At, 1, 1); PG8_STAGE(PG8_SB(1, 0), b3, voffB); PG8_STAGE(PG8_SB(1, 1), b3 + hstepB, voffB); PG8_STAGE(PG8_SA(1, 0), a3, voffA);
      PG8_WAIT_V(8); PG8_WAIT_L(0); PG8_BAR; PG8_MMA(1, 0, At, B0); PG8_MMA(1, 1, At, B1); PG8_BAR; PG8_SCHED;
    }
    if constexpr (ALIGN_EPI) { if (wr == 0) PG8_BAR; }
    E(acc, cur, wr, wc, fr, fq, ui & 1, has_next, nxt);
    if (!has_next) break;
#pragma unroll
    for (int a = 0; a < 2; ++a)
#pragma unroll
      for (int b = 0; b < 2; ++b)
#pragma unroll
        for (int m = 0; m < 4; ++m)
#pragma unroll
          for (int n = 0; n < 2; ++n) acc[a][b][m][n] = (f32x4){0.f, 0.f, 0.f, 0.f};
    cur = nxt; cA = nA; cB = nB; ++ui;
    if constexpr (ALIGN_EPI) { if (wr == 1) PG8_BAR; }
  }
  PG8_WAIT_V(0);
  if constexpr (!ALIGN_EPI) { if (wr == 0) PG8_BAR; }
  PG8_BAR;
#undef PG8_SA
#undef PG8_SB
#undef PG8_STAGE
#undef PG8_LDA
#undef PG8_LDB
#undef PG8_MMA
#undef PG8_WAIT_V
#undef PG8_WAIT_L
#undef PG8_BAR
#undef PG8_SCHED
}
}

__device__ __forceinline__ float wave_sum(float v) {
#pragma unroll
  for (int o = 1; o < 64; o <<= 1) v += __shfl_xor(v, o);
  return v;
}
__device__ __forceinline__ void transpose_item(const float* __restrict__ W, int ldw, int srccol, const float* __restrict__ gs, bf16_t* __restrict__ WT, int K, int k0, int n0,
                                               LAS float* scr, int lane) {
  float tv[32];
#pragma unroll
  for (int i = 0; i < 32; ++i) { const int kk = 2 * i + (lane >> 5); tv[i] = __builtin_nontemporal_load(&W[(size_t)(k0 + kk) * ldw + srccol]); }
  if (gs) {
#pragma unroll
    for (int i = 0; i < 32; ++i) tv[i] *= gs[k0 + 2 * i + (lane >> 5)];
  }
#pragma unroll
  for (int i = 0; i < 32; ++i) { const int kk = 2 * i + (lane >> 5); scr[kk * 33 + (lane & 31)] = tv[i]; }
  asm volatile("s_waitcnt lgkmcnt(0)" ::: "memory");
  const int c = lane & 7;
#pragma unroll
  for (int j = 0; j < 4; ++j) { const int n = (lane >> 3) + 8 * j; const LAS float* s = scr + (8 * c) * 33 + n;
    u32x4 o; o.x = pk_bf16(s[0 * 33], s[1 * 33]); o.y = pk_bf16(s[2 * 33], s[3 * 33]); o.z = pk_bf16(s[4 * 33], s[5 * 33]); o.w = pk_bf16(s[6 * 33], s[7 * 33]);
    *(u32x4*)(WT + (size_t)(n0 + n) * K + k0 + 8 * c) = o; }
  asm volatile("s_waitcnt lgkmcnt(0)" ::: "memory");
}

struct Params {
  const float *x, *norm_g, *w_in, *f_bias, *sgu_w, *sgu_b, *sgu_ln_g, *sgu_ln_b, *short_conv_w, *conf_dw_w, *conf_dw_b, *conf_ln_g, *conf_ln_b, *w_branch, *w_out, *final_g;
  float* out; unsigned char* ws;
};

constexpr int I_W1 = 16 * 112, I_WM = 16 * 128, I_WB = 4 * 4 * 32, I_WO = 16 * 32, I_L = I_W1 + I_WM + I_WB + I_WO;
__device__ __forceinline__ void weight_item(const Params& p, int l, int r, LAS float* scr, int lane) {
  unsigned char* ws = p.ws;
  const float* gl = p.norm_g + l * D;
  const float* win = p.w_in + (size_t)l * D * INC;
  if (r < I_W1) { const int kb = r / 112, nb = r % 112, n0 = 32 * nb; const int n = n0 + (lane & 31); const int col = n < 1536 ? n : n + 4;
    transpose_item(win, INC, col, gl, (bf16_t*)(ws + WS_W1T) + (size_t)l * NP * D, D, 64 * kb, n0, scr, lane); return; }
  r -= I_W1;
  if (r < I_WM) { const int kb = r / 128, nb = r % 128, n0 = 32 * nb; const int c = (n0 & 255) + (lane & 31), pnn = n0 >> 8;
    const int bj = c >> 7, wc = (c >> 5) & 3, n = (c >> 4) & 1, low = c & 15; const int col = 3588 + (2 * bj + n) * 1024 + 64 * pnn + 16 * wc + low;
    transpose_item(win, INC, col, gl, (bf16_t*)(ws + WS_WMT) + (size_t)l * 4096 * D, D, 64 * kb, n0, scr, lane); return; }
  r -= I_WM;
  if (r < I_WB) { const int br = r / 128, q = r % 128, kb = q / 32, nb = q % 32, n0 = 32 * nb;
    transpose_item(p.w_branch + ((size_t)l * 4 + br) * 256 * D, D, n0 + (lane & 31), nullptr, (bf16_t*)(ws + WS_WBT) + ((size_t)l * 4 + br) * D * 256, 256, 64 * kb, n0, scr, lane); return; }
  r -= I_WB;
  { const int kb = r / 32, nb = r % 32, n0 = 32 * nb;
    transpose_item(p.w_out + (size_t)l * D * D, D, n0 + (lane & 31), nullptr, (bf16_t*)(ws + WS_WOT) + (size_t)l * D * D, D, 64 * kb, n0, scr, lane); }
}

__device__ __forceinline__ void p0_prologue(const Params& p, LAS unsigned char* lds, int tid, int lane, int wid, int G, int bx) {
  unsigned char* ws = p.ws;
  LAS float* scr = (LAS float*)(lds + wid * 16384);
  const int gw = bx * 8 + wid, NGW = G * 8;
  for (int it = gw; it < I_L; it += NGW) weight_item(p, 0, it, scr, lane);
  const int gt = bx * 512 + tid, GT = G * 512;
  for (int i = gt; i < 2 * D * 4; i += GT) { const int l = i / (D * 4), k = (i >> 2) & (D - 1), h = i & 3;
    ((float*)(ws + WS_WF))[i] = p.norm_g[l * D + k] * p.w_in[((size_t)l * D + k) * INC + 1536 + h]; }
  for (int i = gt; i < 2 * 4 * 128 * 128; i += GT) { const int s = i & 127, t = (i >> 7) & 127; const float v = (s <= t) ? p.sgu_w[i] : 0.f;
    ((bf16_t*)(ws + WS_SGUW))[i] = (bf16_t)(pk_bf16(v, 0.f) & 0xffffu); }
  {
    f32x4 wv[16];
#pragma unroll
    for (int j = 0; j < 4; ++j)
#pragma unroll
      for (int e = 0; e < 4; ++e) { const int k = 256 * j + 4 * lane + e; const f32x4 w4 = *(const f32x4*)(p.w_in + (size_t)k * INC + 1536); wv[4 * j + e] = w4 * p.norm_g[k]; }
    float* stats = (float*)(ws + WS_STATS);
    bf16_t* xb = (bf16_t*)(ws + WS_XB);
    for (int mm = gw; mm < M; mm += 2 * NGW) {
      const int m2 = mm + NGW; const bool has2 = m2 < M;
      f32x4 va[4], vb[4];
      { const f32x4* xr = (const f32x4*)(p.x + (size_t)mm * D) + lane;
#pragma unroll
        for (int j = 0; j < 4; ++j) va[j] = __builtin_nontemporal_load(&xr[64 * j]); }
      if (has2) { const f32x4* xr = (const f32x4*)(p.x + (size_t)m2 * D) + lane;
#pragma unroll
        for (int j = 0; j < 4; ++j) vb[j] = __builtin_nontemporal_load(&xr[64 * j]); }
      else {
#pragma unroll
        for (int j = 0; j < 4; ++j) vb[j] = (f32x4){0.f, 0.f, 0.f, 0.f}; }
#pragma unroll
      for (int rr = 0; rr < 2; ++rr) {
        const int m = rr == 0 ? mm : m2;
        if (rr == 1 && !has2) break;
        float ss = 0.f, f0 = 0.f, f1 = 0.f, f2 = 0.f, f3 = 0.f;
        u32x2* o8 = (u32x2*)(xb + (size_t)m * D) + lane;
#pragma unroll
        for (int j = 0; j < 4; ++j) { const f32x4 v = rr == 0 ? va[j] : vb[j];
          ss += (v[0] * v[0] + v[1] * v[1]) + (v[2] * v[2] + v[3] * v[3]);
#pragma unroll
          for (int e = 0; e < 4; ++e) { const f32x4 w4 = wv[4 * j + e]; f0 += v[e] * w4[0]; f1 += v[e] * w4[1]; f2 += v[e] * w4[2]; f3 += v[e] * w4[3]; }
          u32x2 w; w.x = pk_bf16(v[0], v[1]); w.y = pk_bf16(v[2], v[3]); o8[64 * j] = w; }
        ss = wave_sum(ss); f0 = wave_sum(f0); f1 = wave_sum(f1); f2 = wave_sum(f2); f3 = wave_sum(f3);
        if (lane < SROW) { const float v = lane == 0 ? ss : lane == 1 ? f0 : lane == 2 ? f1 : lane == 3 ? f2 : lane == 4 ? f3 : 0.f; stats[(size_t)m * SROW + lane] = v; }
      }
    }
  }
}

__device__ __forceinline__ void conv_c(const bf16_t* __restrict__ proj, bf16_t* __restrict__ Y, const float* __restrict__ w, int m0, int tid, int pass0) {
  const int c8 = (tid & 31) * 8, rs = tid >> 5;
  float w0[8], w1[8], w2[8];
#pragma unroll
  for (int e = 0; e < 8; ++e) { w0[e] = w[c8 + e]; w1[e] = w[256 + c8 + e]; w2[e] = w[512 + c8 + e]; }
#pragma unroll 4
  for (int pq = 0; pq < 4; ++pq) {
    const int pass = pass0 + pq;
    const int m = m0 + pass * 16 + rs; const int s = m & (SEQ - 1);
    const bf16_t* row = proj + (size_t)m * NP;
    const u32x4 Bv = *(const u32x4*)(row + PC_CB + c8), Gv = *(const u32x4*)(row + PC_CG + c8);
    const u32x4 Cc0 = *(const u32x4*)(row + PC_CC + c8), Xx0 = *(const u32x4*)(row + PC_CX + c8);
    u32x4 Cc1 = {0, 0, 0, 0}, Xx1 = {0, 0, 0, 0}, Cc2 = {0, 0, 0, 0}, Xx2 = {0, 0, 0, 0};
    if (s >= 1) { Cc1 = *(const u32x4*)(row - NP + PC_CC + c8); Xx1 = *(const u32x4*)(row - NP + PC_CX + c8); }
    if (s >= 2) { Cc2 = *(const u32x4*)(row - 2 * NP + PC_CC + c8); Xx2 = *(const u32x4*)(row - 2 * NP + PC_CX + c8); }
    float b[8], g[8], c0[8], x0[8], c1[8], x1[8], c2[8], x2[8], y[8];
    unpack8(Bv, b); unpack8(Gv, g); unpack8(Cc0, c0); unpack8(Xx0, x0); unpack8(Cc1, c1); unpack8(Xx1, x1); unpack8(Cc2, c2); unpack8(Xx2, x2);
#pragma unroll
    for (int e = 0; e < 8; ++e) { const float cv = w0[e] * (c2[e] * x2[e]) + w1[e] * (c1[e] * x1[e]) + w2[e] * (c0[e] * x0[e]); y[e] = b[e] * cv * g[e]; }
    u32x4 o; o.x = pk_bf16(y[0], y[1]); o.y = pk_bf16(y[2], y[3]); o.z = pk_bf16(y[4], y[5]); o.w = pk_bf16(y[6], y[7]);
    *(u32x4*)(Y + (size_t)m * D + 512 + c8) = o;
  }
}

__device__ __forceinline__ void conv_d(LAS unsigned char* lds, const bf16_t* __restrict__ proj, bf16_t* __restrict__ Y, const float* __restrict__ dw, const float* __restrict__ db,
                                       const float* __restrict__ lg, const float* __restrict__ lb, int m0, int tid, int sub0) {
  constexpr int HP = 260, TT = 32, HR = TT + 30;
  LAS float* H = (LAS float*)lds;
  LAS float* YB = (LAS float*)(lds + 65536);
  const int c = tid & 255, tg = tid >> 8;
  float w[31];
#pragma unroll
  for (int k = 0; k < 31; ++k) w[k] = dw[k * 256 + c];
  const float bias = db[c];
  u32x4 ha[4], hs[4];
#define CD_LOAD(mb_) do { const int sb_ = (mb_) & (SEQ - 1); _Pragma("unroll") for (int it = 0; it < 4; ++it) { const int idx = tid + 512 * it; const int j = idx >> 5, c8 = (idx & 31) * 8; \
      ha[it] = (u32x4){0u, 0u, 0u, 0u}; hs[it] = (u32x4){0u, 0u, 0u, 0u}; \
      if (idx < HR * 32 && sb_ + j - 30 >= 0) { const bf16_t* row = proj + (size_t)((mb_) - 30 + j) * NP; ha[it] = *(const u32x4*)(row + PC_DA + c8); hs[it] = *(const u32x4*)(row + PC_DS + c8); } } } while (0)
#define CD_WRITE() do { _Pragma("unroll") for (int it = 0; it < 4; ++it) { const int idx = tid + 512 * it; const int j = idx >> 5, c8 = (idx & 31) * 8; \
      if (idx < HR * 32) { float a[8], sg[8]; unpack8(ha[it], a); unpack8(hs[it], sg); \
        *(LAS f32x4*)(H + j * HP + c8) = (f32x4){a[0] * sg[0], a[1] * sg[1], a[2] * sg[2], a[3] * sg[3]}; *(LAS f32x4*)(H + j * HP + c8 + 4) = (f32x4){a[4] * sg[4], a[5] * sg[5], a[6] * sg[6], a[7] * sg[7]}; } } } while (0)
  CD_LOAD(m0 + sub0 * TT);
#pragma unroll 1
  for (int sub = sub0; sub < sub0 + 2; ++sub) {
    const int mb = m0 + sub * TT;
    CD_WRITE();
    __syncthreads();
    if (sub + 1 < sub0 + 2) CD_LOAD(mb + TT);
    const bf16_t* grow_ = proj + (size_t)(mb + (tid >> 4)) * NP + PC_DG + 16 * (tid & 15);
    const u32x4 gpre0 = *(const u32x4*)(grow_), gpre1 = *(const u32x4*)(grow_ + 8);
#pragma unroll 1
    for (int i = 0; i < 4; ++i) {
      const int tl = tg * 16 + 4 * i;
      float a0 = bias, a1 = bias, a2 = bias, a3 = bias;
#pragma unroll
      for (int k = 0; k < 34; ++k) {
        const float hv = H[(tl + k) * HP + c];
        if (k <= 30) a0 += w[k <= 30 ? k : 0] * hv;
        if (k >= 1 && k <= 31) a1 += w[(k >= 1 && k <= 31) ? k - 1 : 0] * hv;
        if (k >= 2 && k <= 32) a2 += w[(k >= 2 && k <= 32) ? k - 2 : 0] * hv;
        if (k >= 3) a3 += w[k >= 3 ? k - 3 : 0] * hv;
      }
      YB[(tl + 0) * HP + c] = a0; YB[(tl + 1) * HP + c] = a1; YB[(tl + 2) * HP + c] = a2; YB[(tl + 3) * HP + c] = a3;
    }
    __syncthreads();
    {
      const int r = tid >> 4, q = tid & 15; const int m = mb + r;
      f32x4 v[4]; float s1 = 0.f, s2 = 0.f;
#pragma unroll
      for (int e = 0; e < 4; ++e) { v[e] = *(const LAS f32x4*)(YB + r * HP + 16 * q + 4 * e); s1 += (v[e][0] + v[e][1]) + (v[e][2] + v[e][3]);
        s2 += (v[e][0] * v[e][0] + v[e][1] * v[e][1]) + (v[e][2] * v[e][2] + v[e][3] * v[e][3]); }
#pragma unroll
      for (int o = 1; o < 16; o <<= 1) { s1 += __shfl_xor(s1, o); s2 += __shfl_xor(s2, o); }
      const float mu = s1 * (1.0f / 256.0f); const float var = fmaxf(s2 * (1.0f / 256.0f) - mu * mu, 0.f); const float rstd = rsqrtf(var + EPS);
      float gt[16]; unpack8(gpre0, gt); unpack8(gpre1, gt + 8);
      float o[16];
#pragma unroll
      for (int e = 0; e < 4; ++e) { const f32x4 g4 = *(const f32x4*)(lg + 16 * q + 4 * e), b4 = *(const f32x4*)(lb + 16 * q + 4 * e);
#pragma unroll
        for (int j = 0; j < 4; ++j) { const float z = (v[e][j] - mu) * rstd * g4[j] + b4[j]; o[4 * e + j] = z * fast_sigmoid(z) * gt[4 * e + j]; } }
      u32x4 o0, o1; o0.x = pk_bf16(o[0], o[1]); o0.y = pk_bf16(o[2], o[3]); o0.z = pk_bf16(o[4], o[5]); o0.w = pk_bf16(o[6], o[7]);
      o1.x = pk_bf16(o[8], o[9]); o1.y = pk_bf16(o[10], o[11]); o1.z = pk_bf16(o[12], o[13]); o1.w = pk_bf16(o[14], o[15]);
      bf16_t* yo = Y + (size_t)m * D + 768 + 16 * q;
      *(u32x4*)yo = o0; *(u32x4*)(yo + 8) = o1;
    }
    __syncthreads();
  }
#undef CD_LOAD
#undef CD_WRITE
}

__device__ __forceinline__ void gmlp_unit(LAS unsigned char* lds, const bf16_t* __restrict__ proj, bf16_t* __restrict__ Y, const bf16_t* __restrict__ sw  ,
                                          const float* __restrict__ sb  , const float* __restrict__ lg, const float* __restrict__ lb, int m0, int tid) {
  constexpr int VP = 136;
  LAS bf16_t* vnT = (LAS bf16_t*)lds;
  {
    const int r = tid >> 2, q = tid & 3;
    const bf16_t* vrow = proj + (size_t)(m0 + r) * NP + PC_V + 64 * q;
    float v[64]; float s1 = 0.f;
#pragma unroll
    for (int e = 0; e < 8; ++e) { unpack8(*(const u32x4*)(vrow + 8 * e), v + 8 * e); }
#pragma unroll
    for (int e = 0; e < 64; ++e) s1 += v[e];
    s1 += __shfl_xor(s1, 1); s1 += __shfl_xor(s1, 2);
    const float mu = s1 * (1.0f / 256.0f); float s2 = 0.f;
#pragma unroll
    for (int e = 0; e < 64; ++e) { const float d = v[e] - mu; s2 += d * d; }
    s2 += __shfl_xor(s2, 1); s2 += __shfl_xor(s2, 2);
    const float rstd = rsqrtf(s2 * (1.0f / 256.0f) + EPS);
#pragma unroll
    for (int e = 0; e < 64; ++e) { const int ch = 64 * q + e; const float z = (v[e] - mu) * rstd * lg[ch] + lb[ch]; vnT[ch * VP + r] = (bf16_t)(pk_bf16(z, 0.f) & 0xffffu); }
  }
  __syncthreads();
  {
    const int lane = tid & 63, wid = tid >> 6, r32 = lane & 31, hi = lane >> 5; const int h = wid >> 1, th = wid & 1;
    f32x16 acc[2][2];
#pragma unroll
    for (int a = 0; a < 2; ++a)
#pragma unroll
      for (int b = 0; b < 2; ++b)
#pragma unroll
        for (int r = 0; r < 16; ++r) acc[a][b][r] = 0.f;
    const bf16_t* wbase = sw + (size_t)h * 128 * 128 + (size_t)(64 * th + r32) * 128 + 8 * hi;
    const LAS bf16_t* abase = vnT + (64 * h + r32) * VP + 8 * hi;
#pragma unroll
    for (int ks = 0; ks < 8; ++ks) {
      bf16x8 a0 = *(const LAS bf16x8*)(abase + 16 * ks), a1 = *(const LAS bf16x8*)(abase + 32 * VP + 16 * ks);
      bf16x8 b0 = *(const bf16x8*)(wbase + 16 * ks), b1 = *(const bf16x8*)(wbase + 32 * 128 + 16 * ks);
      acc[0][0] = __builtin_amdgcn_mfma_f32_32x32x16_bf16(a0, b0, acc[0][0], 0, 0, 0);
      acc[0][1] = __builtin_amdgcn_mfma_f32_32x32x16_bf16(a0, b1, acc[0][1], 0, 0, 0);
      acc[1][0] = __builtin_amdgcn_mfma_f32_32x32x16_bf16(a1, b0, acc[1][0], 0, 0, 0);
      acc[1][1] = __builtin_amdgcn_mfma_f32_32x32x16_bf16(a1, b1, acc[1][1], 0, 0, 0);
    }
    __syncthreads();
    LAS float* stg = (LAS float*)lds;
#pragma unroll
    for (int tb = 0; tb < 2; ++tb) {
      const int t = 64 * th + 32 * tb + r32; const float bt = sb[h * 128 + t];
#pragma unroll
      for (int db = 0; db < 2; ++db)
#pragma unroll
        for (int g = 0; g < 4; ++g) {
          const int chunk = (64 * h + 32 * db + 8 * g + 4 * hi) >> 2;
          *(LAS f32x4*)(stg + t * 256 + ((chunk ^ (t & 63)) << 2)) = (f32x4){acc[db][tb][4 * g + 0] + bt, acc[db][tb][4 * g + 1] + bt, acc[db][tb][4 * g + 2] + bt, acc[db][tb][4 * g + 3] + bt};
        }
    }
    __syncthreads();
    {
      const int c8 = (tid & 31) * 8, rs = tid >> 5;
#pragma unroll 4
      for (int pass = 0; pass < 8; ++pass) {
        const int t = pass * 16 + rs;
        const bf16_t* prow = proj + (size_t)(m0 + t) * NP;
        float uu[8], gg[8]; unpack8(*(const u32x4*)(prow + PC_U + c8), uu); unpack8(*(const u32x4*)(prow + PC_AG + c8), gg);
        const int ck = c8 >> 2;
        const f32x4 a = *(const LAS f32x4*)(stg + t * 256 + ((ck ^ (t & 63)) << 2)), c = *(const LAS f32x4*)(stg + t * 256 + (((ck + 1) ^ (t & 63)) << 2));
        u32x4 o; o.x = pk_bf16(uu[0] * a[0] * gg[0], uu[1] * a[1] * gg[1]); o.y = pk_bf16(uu[2] * a[2] * gg[2], uu[3] * a[3] * gg[3]);
        o.z = pk_bf16(uu[4] * c[0] * gg[4], uu[5] * c[1] * gg[5]); o.w = pk_bf16(uu[6] * c[2] * gg[6], uu[7] * c[3] * gg[7]);
        *(u32x4*)(Y + (size_t)(m0 + t) * D + c8) = o;
      }
    }
  }
  __syncthreads();
}

constexpr int AT_K = 0, AT_V = 16384, AT_CUM = 40960, AT_WSF = 57344, AT_SCAN = 59392, AT_OST = 61440;
constexpr float SKIP_THR = 100.0f, THRL = 64.0f;
__device__ __forceinline__ int crow(int r, int hi) { return (r & 3) + 8 * (r >> 2) + 4 * hi; }
__device__ __forceinline__ unsigned bf_rne(float v) { return pk_bf16(v, 0.f) & 0xffffu; }
__device__ __forceinline__ bf16x8 split3(float v, bool first, bool active) {
  const unsigned h = bf_rne(v); const float r1 = v - __uint_as_float(h << 16);
  const unsigned m = bf_rne(r1); const float r2 = r1 - __uint_as_float(m << 16);
  const unsigned l = bf_rne(r2);
  const unsigned one = 0x3f80u;
  u32x4 w;
  if (first) { w.x = h | (m << 16); w.y = l | (one << 16); w.z = one | (one << 16); w.w = 0u; }
  else       { w.x = one | (one << 16); w.y = one | (h << 16); w.z = m | (l << 16); w.w = 0u; }
  if (!active) { w.x = 0u; w.y = 0u; w.z = 0u; }
  return __builtin_bit_cast(bf16x8, w);
}

struct AttnState { float mhat, lsum; f32x16 o0, o1; bf16x8 qx; };

struct AttnP { bf16x8 pa[4]; bool resc; };
__device__ __forceinline__ void attn_front(AttnState& S, AttnP& P, const LAS unsigned char* Ks, const LAS float* cum, LAS float* wsf, const bf16x8 (&qr)[4],
                                           float cref, int t, int q0w, int qrow, int r32, int hi) {
  const bf16x8 kx0 = split3(cref - cum[64 * t + r32], true, hi == 0), kx1 = split3(cref - cum[64 * t + 32 + r32], true, hi == 0);
  f32x16 p0, p1;
#pragma unroll
  for (int r = 0; r < 16; ++r) { p0[r] = 0.f; p1[r] = 0.f; }
  p0 = __builtin_amdgcn_mfma_f32_32x32x16_bf16(kx0, S.qx, p0, 0, 0, 0);
  p1 = __builtin_amdgcn_mfma_f32_32x32x16_bf16(kx1, S.qx, p1, 0, 0, 0);
  const LAS unsigned char* kb = Ks + hi * 1024 + r32 * 16;
#pragma unroll
  for (int d0 = 0; d0 < 4; ++d0) {
    const bf16x8 k0 = *(const LAS bf16x8*)(kb + d0 * 2048), k1 = *(const LAS bf16x8*)(kb + d0 * 2048 + 512);
    p0 = __builtin_amdgcn_mfma_f32_32x32x16_bf16(k0, qr[d0], p0, 0, 0, 0);
    p1 = __builtin_amdgcn_mfma_f32_32x32x16_bf16(k1, qr[d0], p1, 0, 0, 0);
  }
  if (64 * t + 63 > q0w) {
#pragma unroll
    for (int r = 0; r < 16; ++r) { const int kv = 64 * t + crow(r, hi); if (kv > qrow) p0[r] = -INFINITY; if (kv + 32 > qrow) p1[r] = -INFINITY; }
  }
  float rm = fmaxf(fmaxf(p0[0], p0[1]), p1[0]);
#pragma unroll
  for (int r = 2; r < 16; r += 2) rm = fmaxf(fmaxf(rm, p0[r]), p0[r + 1]);
#pragma unroll
  for (int r = 1; r < 16; r += 2) rm = fmaxf(fmaxf(rm, p1[r]), p1[(r + 1) & 15]);
  rm = fmaxf(rm, __shfl_xor(rm, 32));
  const bool resc = __any(rm > THRL);
  if (resc) {
    const float dl = fmaxf(rm, 0.f); S.mhat += dl;
#pragma unroll
    for (int r = 0; r < 16; ++r) { p0[r] -= dl; p1[r] -= dl; }
    const float f = __builtin_amdgcn_exp2f(-dl); S.lsum *= f;
    if (hi == 0) wsf[r32] = f;
    S.qx = split3(-S.mhat, false, hi == 0);
  }
  float ps = 0.f;
#pragma unroll
  for (int r = 0; r < 16; ++r) { p0[r] = __builtin_amdgcn_exp2f(p0[r]); p1[r] = __builtin_amdgcn_exp2f(p1[r]); ps += p0[r] + p1[r]; }
  S.lsum += ps;
  { u32x4 w;
    w.x = pk_bf16(p0[0], p0[1]); w.y = pk_bf16(p0[2], p0[3]); w.z = pk_bf16(p0[4], p0[5]); w.w = pk_bf16(p0[6], p0[7]); P.pa[0] = __builtin_bit_cast(bf16x8, w);
    w.x = pk_bf16(p0[8], p0[9]); w.y = pk_bf16(p0[10], p0[11]); w.z = pk_bf16(p0[12], p0[13]); w.w = pk_bf16(p0[14], p0[15]); P.pa[1] = __builtin_bit_cast(bf16x8, w);
    w.x = pk_bf16(p1[0], p1[1]); w.y = pk_bf16(p1[2], p1[3]); w.z = pk_bf16(p1[4], p1[5]); w.w = pk_bf16(p1[6], p1[7]); P.pa[2] = __builtin_bit_cast(bf16x8, w);
    w.x = pk_bf16(p1[8], p1[9]); w.y = pk_bf16(p1[10], p1[11]); w.z = pk_bf16(p1[12], p1[13]); w.w = pk_bf16(p1[14], p1[15]); P.pa[3] = __builtin_bit_cast(bf16x8, w); }
  P.resc = resc;
}

__device__ __forceinline__ void attn_back(AttnState& S, const AttnP& P, const LAS unsigned char* Vs, const LAS float* wsf, int lane, int hi) {
  const bool resc = P.resc;
  if (resc) {
#pragma unroll
    for (int g = 0; g < 4; ++g) { const f32x4 ff = *(const LAS f32x4*)(wsf + 8 * g + 4 * hi);
#pragma unroll
      for (int j = 0; j < 4; ++j) { S.o0[4 * g + j] *= ff[j]; S.o1[4 * g + j] *= ff[j]; } }
  }
  const LAS unsigned char* vb = Vs + ((lane >> 4) & 1) * 32 + (lane & 3) * 8 + (4 * hi + ((lane & 15) >> 2)) * 64;
  s16x4 lo0[4], hh0[4], lo1[4], hh1[4];
#pragma unroll
  for (int ks = 0; ks < 4; ++ks) {
    lo0[ks] = __builtin_bit_cast(s16x4, __builtin_amdgcn_ds_read_tr16_b64_v4i16((LAS s16x4*)(vb + ks * 1024)));
    hh0[ks] = __builtin_bit_cast(s16x4, __builtin_amdgcn_ds_read_tr16_b64_v4i16((LAS s16x4*)(vb + ks * 1024 + 512)));
    lo1[ks] = __builtin_bit_cast(s16x4, __builtin_amdgcn_ds_read_tr16_b64_v4i16((LAS s16x4*)(vb + 4096 + ks * 1024)));
    hh1[ks] = __builtin_bit_cast(s16x4, __builtin_amdgcn_ds_read_tr16_b64_v4i16((LAS s16x4*)(vb + 4096 + ks * 1024 + 512)));
  }
  asm volatile("s_waitcnt lgkmcnt(0)" ::: "memory");
#pragma unroll
  for (int ks = 0; ks < 4; ++ks) {
    const bf16x8 v0 = {lo0[ks][0], lo0[ks][1], lo0[ks][2], lo0[ks][3], hh0[ks][0], hh0[ks][1], hh0[ks][2], hh0[ks][3]};
    const bf16x8 v1 = {lo1[ks][0], lo1[ks][1], lo1[ks][2], lo1[ks][3], hh1[ks][0], hh1[ks][1], hh1[ks][2], hh1[ks][3]};
    S.o0 = __builtin_amdgcn_mfma_f32_32x32x16_bf16(P.pa[ks], v0, S.o0, 0, 0, 0);
    S.o1 = __builtin_amdgcn_mfma_f32_32x32x16_bf16(P.pa[ks], v1, S.o1, 0, 0, 0);
  }
}

__device__ __forceinline__ void attn_unit(LAS unsigned char* lds, const bf16_t* __restrict__ proj, bf16_t* __restrict__ Y, const float* __restrict__ stats, float fbias,
                                          int b, int h, int qb, int tid, bool do_scan) {
  const int lane = tid & 63, wid = __builtin_amdgcn_readfirstlane(tid >> 6), r32 = lane & 31, hi = lane >> 5;
  const int q0 = qb * 256; const size_t rowbase = (size_t)b * SEQ;
  LAS float* cum = (LAS float*)(lds + AT_CUM);
  LAS float* wsf = (LAS float*)(lds + AT_WSF) + wid * 64;
  LAS float* scan = (LAS float*)(lds + AT_SCAN);
  const int NT = (q0 + 256) / 64;
  const int qrow = q0 + wid * 32 + r32;
  const bf16_t* Qw = proj + (rowbase + qrow) * NP + PC_Q + h * 64;
  bf16x8 qr[4];
#pragma unroll
  for (int d0 = 0; d0 < 4; ++d0) qr[d0] = *(const bf16x8*)(Qw + d0 * 16 + hi * 8);
  if (do_scan) {
    const int i0 = tid * 8; float lf[8]; float run = 0.f;
#pragma unroll
    for (int e = 0; e < 8; ++e) {
      float v = 0.f;
      if (i0 + e < q0 + 256) { const float* st = stats + (rowbase + i0 + e) * SROW; const float rs = row_rstd(st); const float z = rs * ((st[1 + h] + st[9 + h]) + (st[17 + h] + st[25 + h])) + fbias;
        v = fminf(z, 0.f) - 0.6931471805599453f * __builtin_amdgcn_logf(1.0f + __builtin_amdgcn_exp2f(-LOG2E * fabsf(z))); }
      run += v; lf[e] = run;
    }
    float incl = run;
#pragma unroll
    for (int o = 1; o < 64; o <<= 1) { const float n = __shfl_up(incl, o); if (lane >= o) incl += n; }
    if (lane == 63) scan[wid] = incl;
    __syncthreads();
    float woff = 0.f;
#pragma unroll
    for (int w = 0; w < 8; ++w) if (w < wid) woff += scan[w];
    const float excl = woff + incl - run;
    f32x4 c0 = {(excl + lf[0]) * LOG2E, (excl + lf[1]) * LOG2E, (excl + lf[2]) * LOG2E, (excl + lf[3]) * LOG2E};
    f32x4 c1 = {(excl + lf[4]) * LOG2E, (excl + lf[5]) * LOG2E, (excl + lf[6]) * LOG2E, (excl + lf[7]) * LOG2E};
    *(LAS f32x4*)(cum + i0) = c0; *(LAS f32x4*)(cum + i0 + 4) = c1;
  }
  __syncthreads();
  const float cref = cum[q0];
  int t0;
  { const bool ok = (lane < NT) ? (cum[64 * lane + 63] - cref <= SKIP_THR) : false; const unsigned long long mk = __ballot(ok); t0 = __builtin_amdgcn_readfirstlane((int)__builtin_ctzll(mk)); }
  const bf16_t* Kh = proj + rowbase * NP + PC_K + h * 64; const bf16_t* Vh = proj + rowbase * NP + PC_VV + h * 64;
  const bf16_t* ksrc = Kh + (size_t)lane * NP + wid * 8;
  const bf16_t* vsrc = Vh + (size_t)((tid >> 2) & 63) * NP + (tid >> 8) * 32 + (tid & 3) * 8;
  u32x4 kA = *(const u32x4*)(ksrc + (size_t)t0 * 64 * NP), vA = *(const u32x4*)(vsrc + (size_t)t0 * 64 * NP), kB = kA, vB = vA;
  if (t0 + 1 < NT) { kB = *(const u32x4*)(ksrc + (size_t)(t0 + 1) * 64 * NP); vB = *(const u32x4*)(vsrc + (size_t)(t0 + 1) * 64 * NP); }
  *(LAS u32x4*)(lds + AT_K + tid * 16) = kA; *(LAS u32x4*)(lds + AT_V + tid * 16) = vA;
  __syncthreads();
  AttnState S; S.mhat = 0.f; S.lsum = 0.f;
#pragma unroll
  for (int r = 0; r < 16; ++r) { S.o0[r] = 0.f; S.o1[r] = 0.f; }
  S.qx = split3(0.f, false, hi == 0);
  const int q0w = q0 + wid * 32, qmax_w = q0w + 31;
  const bool late = wid >= 4;
  AttnP Pc; Pc.resc = false; bool pend = false; int vprev = 0;
#pragma unroll
  for (int k = 0; k < 4; ++k) Pc.pa[k] = (bf16x8){0, 0, 0, 0, 0, 0, 0, 0};
  int vs = 0;
#pragma unroll 1
  for (int t = t0; t < NT; t += 2) {
    if (t + 2 < NT) { kA = *(const u32x4*)(ksrc + (size_t)(t + 2) * 64 * NP); vA = *(const u32x4*)(vsrc + (size_t)(t + 2) * 64 * NP); }
    if (late && pend) { attn_back(S, Pc, lds + AT_V + vprev * 8192, wsf, lane, hi); pend = false; }
    if (64 * t <= qmax_w) {
      attn_front(S, Pc, lds + AT_K, cum, wsf, qr, cref, t, q0w, qrow, r32, hi);
      if (!late) attn_back(S, Pc, lds + AT_V + vs * 8192, wsf, lane, hi); else { pend = true; vprev = vs; }
    }
    { const int vn = (vs == 2) ? 0 : vs + 1;
      if (t + 1 < NT) { *(LAS u32x4*)(lds + AT_K + 8192 + tid * 16) = kB; *(LAS u32x4*)(lds + AT_V + vn * 8192 + tid * 16) = vB; }
      vs = vn; }
    __syncthreads();
    if (t + 1 >= NT) break;
    if (t + 3 < NT) { kB = *(const u32x4*)(ksrc + (size_t)(t + 3) * 64 * NP); vB = *(const u32x4*)(vsrc + (size_t)(t + 3) * 64 * NP); }
    if (late && pend) { attn_back(S, Pc, lds + AT_V + vprev * 8192, wsf, lane, hi); pend = false; }
    if (64 * (t + 1) <= qmax_w) {
      attn_front(S, Pc, lds + AT_K + 8192, cum, wsf, qr, cref, t + 1, q0w, qrow, r32, hi);
      if (!late) attn_back(S, Pc, lds + AT_V + vs * 8192, wsf, lane, hi); else { pend = true; vprev = vs; }
    }
    { const int vn = (vs == 2) ? 0 : vs + 1;
      if (t + 2 < NT) { *(LAS u32x4*)(lds + AT_K + tid * 16) = kA; *(LAS u32x4*)(lds + AT_V + vn * 8192 + tid * 16) = vA; }
      vs = vn; }
    __syncthreads();
  }
  if (late && pend) attn_back(S, Pc, lds + AT_V + vprev * 8192, wsf, lane, hi);
  float lsum = S.lsum; lsum += __shfl_xor(lsum, 32);
  if (hi == 0) wsf[r32] = __builtin_amdgcn_rcpf(lsum);
  LAS float* stg = (LAS float*)(lds + AT_OST) + wid * 2048;
#pragma unroll
  for (int g = 0; g < 4; ++g) { const f32x4 ff = *(const LAS f32x4*)(wsf + 8 * g + 4 * hi);
#pragma unroll
    for (int j = 0; j < 4; ++j) { const int q = 8 * g + 4 * hi + j; stg[q * 64 + r32] = S.o0[4 * g + j] * ff[j]; stg[q * 64 + 32 + r32] = S.o1[4 * g + j] * ff[j]; } }
#pragma unroll
  for (int i = 0; i < 4; ++i) {
    const int row = i * 8 + (lane >> 3), ch = lane & 7;
    const f32x4 a = *(const LAS f32x4*)(stg + row * 64 + ch * 8), c = *(const LAS f32x4*)(stg + row * 64 + ch * 8 + 4);
    const size_t grow = rowbase + q0 + wid * 32 + row;
    float gt[8]; unpack8(*(const u32x4*)(proj + grow * NP + PC_BG + h * 64 + ch * 8), gt);
    u32x4 w; w.x = pk_bf16(a[0] * gt[0], a[1] * gt[1]); w.y = pk_bf16(a[2] * gt[2], a[3] * gt[3]); w.z = pk_bf16(c[0] * gt[4], c[1] * gt[5]); w.w = pk_bf16(c[2] * gt[6], c[3] * gt[7]);
    *(u32x4*)(Y + grow * D + 256 + h * 64 + ch * 8) = w;
  }
  __syncthreads();
}

#define XB_TMO      128
#define XB_XCNT(j)  (256  + 64 * (j))
#define XB_XSUB(j)  (1280 + 64 * (j))
#define XB_XGEN(j)  (2304 + 64 * (j))
#define XB_TOP      3328
#define XB_TOPGEN   3392
#define XCD_BAR_WORDS 3456
#define XB_SPIN_CAP (1u << 18)
__device__ __forceinline__ unsigned xb_ld(unsigned* p)              { return __hip_atomic_load(p, __ATOMIC_RELAXED, __HIP_MEMORY_SCOPE_AGENT); }
__device__ __forceinline__ unsigned xb_add(unsigned* p, unsigned v) { return __hip_atomic_fetch_add(p, v, __ATOMIC_RELAXED, __HIP_MEMORY_SCOPE_AGENT); }
__device__ __forceinline__ unsigned xb_xcc_id() { return (unsigned)__builtin_amdgcn_s_getreg((3 << 11) | 20) & 0xFu; }
#define XB_SPIN(cond, bar) do { unsigned _sp = 0; while (cond) { __builtin_amdgcn_s_sleep(1); \
    if ((++_sp & 255u) == 0u) { if (xb_ld(&(bar)[XB_TMO])) break; if (_sp > XB_SPIN_CAP) { atomicAdd(&(bar)[XB_TMO], 1u); break; } } } } while (0)
struct XcdBarrier { unsigned* bar; unsigned x; volatile LAS unsigned* st; };
__device__ __forceinline__ XcdBarrier xcd_barrier_post(unsigned* bar, volatile LAS unsigned* st) {
  XcdBarrier b; b.bar = bar; b.x = xb_xcc_id(); b.st = st;
  if (threadIdx.x == 0) (void)xb_add(&bar[XB_XCNT(b.x)], 1u);
  return b;
}
__device__ __forceinline__ void xcd_barrier_complete(unsigned* bar, unsigned x, unsigned& nloc, unsigned& nx) {
  const unsigned G = gridDim.x * gridDim.y * gridDim.z;
  unsigned sum, cnt, mine, sp = 0u;
  for (;;) {
    sum = 0u; cnt = 0u; mine = 0u;
#pragma unroll
    for (unsigned j = 0; j < 16; ++j) { const unsigned c = xb_ld(&bar[XB_XCNT(j)]); sum += c; cnt += (c > 0u) ? 1u : 0u; mine = (j == x) ? c : mine; }
    if (sum == G) break;
    __builtin_amdgcn_s_sleep(1);
    if ((++sp & 255u) == 0u) { if (xb_ld(&bar[XB_TMO])) break; if (sp > XB_SPIN_CAP) { atomicAdd(&bar[XB_TMO], 1u); break; } }
  }
  nloc = mine > 0u ? mine : 1u; nx = cnt > 0u ? cnt : 1u;
}
__device__ __forceinline__ void xcd_barrier(const XcdBarrier& b_) {
  asm volatile("s_waitcnt vmcnt(0)" ::: "memory");
  __syncthreads();
  if (threadIdx.x == 0) {
    XcdBarrier b; b.bar = b_.bar; b.st = b_.st; b.x = (unsigned)__builtin_amdgcn_readfirstlane((int)xb_xcc_id());
    unsigned* bar = b.bar;
    __builtin_amdgcn_s_waitcnt(0);
    unsigned nloc = b.st[0], nx = b.st[1];
    if (nloc == 0u) { xcd_barrier_complete(bar, b.x, nloc, nx); b.st[0] = nloc; b.st[1] = nx; }
    const unsigned old = xb_add(&bar[XB_XSUB(b.x)], 1u);
    const unsigned gen = old / nloc;
    if (old + 1u == (gen + 1u) * nloc) {
      __builtin_amdgcn_fence(__ATOMIC_RELEASE, "agent");
      asm volatile("s_waitcnt vmcnt(0)" ::: "memory");
      const unsigned og = xb_add(&bar[XB_TOP], 1u);
      const unsigned tg = og / nx;
      if (og + 1u == (tg + 1u) * nx) xb_add(&bar[XB_TOPGEN], 1u);
      else XB_SPIN(xb_ld(&bar[XB_TOPGEN]) == tg, bar);
      __builtin_amdgcn_fence(__ATOMIC_ACQUIRE, "agent");
      xb_add(&bar[XB_XGEN(b.x)], 1u);
      asm volatile("s_waitcnt vmcnt(0)" ::: "memory");
    } else {
      XB_SPIN(xb_ld(&bar[XB_XGEN(b.x)]) == gen, bar);
      __builtin_amdgcn_fence(__ATOMIC_ACQUIRE, "agent");
      asm volatile("s_waitcnt vmcnt(0)" ::: "memory");
    }
  }
  __syncthreads();
}

__global__ void __launch_bounds__(512, 2) fwd(Params p) {
  extern __shared__ __attribute__((aligned(16))) unsigned char lds_raw[];
  cg::grid_group grid = cg::this_grid();
  LAS unsigned char* lds = (LAS unsigned char*)lds_raw;
  const int tid = threadIdx.x, lane = tid & 63, wid = __builtin_amdgcn_readfirstlane(tid >> 6);
  const int G = gridDim.x, bx = blockIdx.x;
  if (tid < 16) ((LAS unsigned*)(lds + MISC_OFF))[tid] = 0u;
  __syncthreads();
  (void)xcd_barrier_post((unsigned*)(p.ws + WS_CTL), (volatile LAS unsigned*)(lds + MISC_OFF) + 8);
#define PHASE_PTRS() size_t wso_ = 0; asm volatile("" : "+s"(wso_)); unsigned char* ws = p.ws + wso_;     \
  float* stats = (float*)(ws + WS_STATS); bf16_t* xb = (bf16_t*)(ws + WS_XB); bf16_t* proj = (bf16_t*)(ws + WS_R); \
  bf16_t* Pbuf = (bf16_t*)(ws + WS_R); bf16_t* Yb = (bf16_t*)(ws + WS_Y); bf16_t* mrg = (bf16_t*)(ws + WS_MRG); const float* st_l = stats + (size_t)l * M * SROW; \
  (void)stats; (void)xb; (void)proj; (void)Pbuf; (void)Yb; (void)mrg; (void)st_l

#ifndef PH_MASK
#define PH_MASK 0xFF
#endif
#ifndef DUP_PHASE
#define DUP_PHASE 0
#endif
#define GSYNC() do { XcdBarrier xb_; xb_.bar = (unsigned*)(p.ws + WS_CTL); xb_.x = 0; xb_.st = (volatile LAS unsigned*)(lds + MISC_OFF) + 8; xcd_barrier(xb_); if (DUP_PHASE == 5) xcd_barrier(xb_); } while (0)
#define REP(k) _Pragma("unroll 1") for (int rep_ = 0; rep_ < ((DUP_PHASE == (k)) ? 2 : 1); ++rep_)
  REP(1) if constexpr (PH_MASK & 1) p0_prologue(p, lds, tid, lane, wid, G, bx);
  if (p.ws == nullptr) grid.sync();
  GSYNC();

  for (int l = 0; l < 2; ++l) {
    REP(2) if constexpr (PH_MASK & 2) {
      PHASE_PTRS();
      pg8::Gemm g{xb, (const bf16_t*)(ws + WS_W1T) + (size_t)l * NP * D, D, D, D};
      pg8::SchedGrid S; S.init(M, NP, G, bx, D, D);
      pg8::Epi1 E{proj, pg8::RstdLds{st_l, lds}};
      pg8::gemm_phase<pg8::Epi1, pg8::SchedGrid, true>(lds, g, S, E);
    }
    GSYNC();
    REP(3) {
      for (int v = bx; v < 256; v += G) {
        PHASE_PTRS();
        const int bh = (v & 7) * 4 + (v >> 6), s = (v >> 3) & 7; const int b = bh >> 2, h = bh & 3; const float fb = p.f_bias[l * 4 + h];
        if constexpr (PH_MASK & 32) { attn_unit(lds, proj, Yb, st_l, fb, b, h, 15 - s, opaque_v(tid), true);
        attn_unit(lds, proj, Yb, st_l, fb, b, h, s, opaque_v(tid), false); }
      }
      {
        unsigned* qctr = (unsigned*)(p.ws + WS_CTL + 14336) + (l * 2 + rep_) * 16;
        volatile LAS unsigned* qw = (volatile LAS unsigned*)(lds + MISC_OFF) + 12;
#pragma unroll 1
        for (;;) {
          if (tid == 0) qw[0] = __hip_atomic_fetch_add(qctr, 1u, __ATOMIC_RELAXED, __HIP_MEMORY_SCOPE_AGENT);
          __syncthreads();
          const int item = (int)qw[0];
          __syncthreads();
          constexpr int WQ = (I_L + 7) / 8;
          if (item >= 768 + (l == 0 ? WQ : 0)) break;
          if (item >= 768) { const int r = (item - 768) * 8 + wid; if (r < I_L) weight_item(p, 1, r, (LAS float*)(lds + wid * 16384), opaque_v(tid) & 63); __syncthreads(); continue; }
          PHASE_PTRS();
          const int m0 = (item / 3) * 128, kind = item % 3;
          int z = 0; asm volatile("" : "+s"(z));
          if (kind < 2) {
            if constexpr (PH_MASK & 4) conv_c(proj, Yb, p.short_conv_w + l * 3 * 256 + z, m0, opaque_v(tid), 4 * kind);
            asm volatile("" : "+s"(z));
            if constexpr (PH_MASK & 8) conv_d(lds, proj, Yb, p.conf_dw_w + l * 31 * 256 + z, p.conf_dw_b + l * 256 + z, p.conf_ln_g + l * 256 + z, p.conf_ln_b + l * 256 + z, m0, opaque_v(tid), 2 * kind);
          } else {
            if constexpr (PH_MASK & 16) gmlp_unit(lds, proj, Yb, (const bf16_t*)(ws + WS_SGUW) + (size_t)l * 4 * 128 * 128 + z, p.sgu_b + l * 4 * 128 + z, p.sgu_ln_g + l * 256 + z, p.sgu_ln_b + l * 256 + z, m0, opaque_v(tid));
          }
          asm volatile("" : "+s"(z));
          __syncthreads();
        }
      }
    }
    GSYNC();
    REP(4) if constexpr (PH_MASK & 64) for (int vc = bx; vc < 256; vc += G) {
      PHASE_PTRS();
      REP(7) {
        pg8::Gemm g{Yb, (const bf16_t*)(ws + WS_WBT) + (size_t)l * 4 * D * 256, D, 256, 256};
        pg8::SchedPB S{vc}; pg8::Epi3a E{Pbuf};
#ifndef NO3A
        pg8::gemm_phase<pg8::Epi3a, pg8::SchedPB, true>(lds, g, S, E);
#endif
      }
      __builtin_amdgcn_fence(__ATOMIC_RELEASE, "workgroup"); __syncthreads(); __builtin_amdgcn_fence(__ATOMIC_ACQUIRE, "workgroup");
      {
        pg8::Gemm g{xb, (const bf16_t*)(ws + WS_WMT) + (size_t)l * 4096 * D, D, D, D};
        pg8::SchedL S{vc}; pg8::Epi3b E{Pbuf, mrg, pg8::RstdLds{st_l, lds}};
#ifndef NO3B
        pg8::gemm_phase<pg8::Epi3b, pg8::SchedL, true>(lds, g, S, E);
#endif
      }
    }
    GSYNC();
    if constexpr (PH_MASK & 128) {
      PHASE_PTRS();
      pg8::Gemm g{mrg, (const bf16_t*)(ws + WS_WOT) + (size_t)l * D * D, D, D, D};
      pg8::SchedGrid S; S.init(M, D, G, bx, D, D);
      float* st_n = stats + (size_t)(l + 1) * M * SROW;
      if (l == 0) { pg8::Epi4<true> E{p.x, nullptr, xb, st_n, (const float*)(ws + WS_WF) + D * 4, lds}; pg8::gemm_phase<pg8::Epi4<true>, pg8::SchedGrid, true>(lds, g, S, E); }
      else        { pg8::Epi4<false> E{nullptr, xb, Yb, st_n, nullptr, lds}; pg8::gemm_phase<pg8::Epi4<false>, pg8::SchedGrid, true>(lds, g, S, E); }
    }
    GSYNC();
  }
  {
    const int l = 2; PHASE_PTRS();
    const int lane = opaque_v(tid) & 63;
    const float* st = st_l;
    f32x4 gv[4];
#pragma unroll
    for (int j = 0; j < 4; ++j) gv[j] = *((const f32x4*)p.final_g + 64 * j + lane);
    for (int m = bx * 8 + wid; m < M; m += G * 8) {
      const float rs = row_rstd(st + (size_t)m * SROW);
      f32x4* xr = (f32x4*)(p.out + (size_t)m * D) + lane; const u32x2* xs = (const u32x2*)(Yb + (size_t)m * D) + lane;
#pragma unroll
      for (int j = 0; j < 4; ++j) { const u32x2 w = __builtin_nontemporal_load(&xs[64 * j]); const f32x4 v = {bf_lo(w.x), bf_hi(w.x), bf_lo(w.y), bf_hi(w.y)}; __builtin_nontemporal_store(v * rs * gv[j], &xr[64 * j]); }
    }
  }
}

extern "C" void kernel_launch(void* const* d_in, const int* in_sizes, int n_in, void* d_out, int out_size, void* d_ws, size_t ws_size, hipStream_t stream) {
  static int grid_blocks = 0;
  if (!grid_blocks) {
    int dev = 0, cus = 0, per_cu = 0;
    (void)hipGetDevice(&dev);
    (void)hipDeviceGetAttribute(&cus, hipDeviceAttributeMultiprocessorCount, dev);
    (void)hipFuncSetAttribute((const void*)fwd, hipFuncAttributeMaxDynamicSharedMemorySize, LDS_BYTES);
    (void)hipOccupancyMaxActiveBlocksPerMultiprocessor(&per_cu, (const void*)fwd, 512, LDS_BYTES);
    if (per_cu < 1) per_cu = 1;
    grid_blocks = cus * per_cu;
    if (grid_blocks > 256) grid_blocks = 256;
    if (ws_size < WS_END || n_in != 16 || out_size != M * D) fprintf(stderr, "kernel_launch: unexpected sizes: ws %zu (need %zu), n_in %d, out %d\n", ws_size, (size_t)WS_END, n_in, out_size);
  }
  (void)hipMemsetAsync((char*)d_ws + WS_CTL, 0, CTL_BYTES, stream);
  Params p{};
  p.x = (const float*)d_in[0]; p.norm_g = (const float*)d_in[1]; p.w_in = (const float*)d_in[2]; p.f_bias = (const float*)d_in[3]; p.sgu_w = (const float*)d_in[4];
  p.sgu_b = (const float*)d_in[5]; p.sgu_ln_g = (const float*)d_in[6]; p.sgu_ln_b = (const float*)d_in[7]; p.short_conv_w = (const float*)d_in[8]; p.conf_dw_w = (const float*)d_in[9];
  p.conf_dw_b = (const float*)d_in[10]; p.conf_ln_g = (const float*)d_in[11]; p.conf_ln_b = (const float*)d_in[12]; p.w_branch = (const float*)d_in[13]; p.w_out = (const float*)d_in[14];
  p.final_g = (const float*)d_in[15]; p.out = (float*)d_out; p.ws = (unsigned char*)d_ws;
  void* args[] = {&p};
  hipError_t e = hipLaunchCooperativeKernel((void*)fwd, dim3(grid_blocks), dim3(512), args, LDS_BYTES, stream);
  if (e != hipSuccess) fprintf(stderr, "cooperative launch failed: %s (grid %d)\n", hipGetErrorString(e), grid_blocks);
}
```

```cpp
#include <hip/hip_runtime.h>
#include <hip/hip_cooperative_groups.h>
#include <cstdio>
#include <cstdint>
namespace cg = cooperative_groups;

#define LAS __attribute__((address_space(3)))
#define GAS __attribute__((address_space(1)))
typedef unsigned short bf16_t;
typedef short bf16x8 __attribute__((ext_vector_type(8)));
typedef short s16x4 __attribute__((ext_vector_type(4)));
typedef float f32x2 __attribute__((ext_vector_type(2)));
typedef float f32x4 __attribute__((ext_vector_type(4)));
typedef float f32x16 __attribute__((ext_vector_type(16)));
typedef unsigned u32x2 __attribute__((ext_vector_type(2)));
typedef unsigned u32x4 __attribute__((ext_vector_type(4)));
typedef __bf16 bf16x2_t __attribute__((ext_vector_type(2)));

constexpr int M = 32768, D = 1024, SEQ = 4096, NP = 3584, INC = 7684, NHEAD = 4;
constexpr float EPS = 1e-6f;
constexpr float LOG2E = 1.4426950408889634f;
constexpr float C2 = 0.125f * LOG2E;
constexpr int PC_U = 0, PC_V = 256, PC_AG = 512, PC_Q = 768, PC_K = 1024, PC_VV = 1280, PC_BG = 1536, PC_CB = 1792, PC_CC = 2048, PC_CX = 2304, PC_CG = 2560,
              PC_DA = 2816, PC_DS = 3072, PC_DG = 3328;
constexpr size_t MiB = 1u << 20;
constexpr size_t WS_STATS = 490 * MiB, WS_WF = 3 * MiB, WS_SGUW = 3 * MiB + 512 * 1024, WS_W1T = 4 * MiB, WS_WMT = 18 * MiB, WS_WBT = 34 * MiB, WS_WOT = 38 * MiB,
                 WS_XB = 42 * MiB, WS_R = 106 * MiB, WS_Y = 362 * MiB, WS_MRG = 426 * MiB, WS_END = 502 * MiB;
constexpr int SROW = 32;
constexpr size_t WS_CTL = 3 * MiB + 128 * 1024, CTL_BYTES = 16384;
constexpr int LDS_BYTES = 147456, MISC_OFF = 131072 + 320;

__device__ __forceinline__ unsigned pk_bf16(float lo, float hi) { f32x2 v = {lo, hi}; bf16x2_t b = __builtin_convertvector(v, bf16x2_t); return __builtin_bit_cast(unsigned, b); }
__device__ __forceinline__ float bf_lo(unsigned u) { return __uint_as_float(u << 16); }
__device__ __forceinline__ float bf_hi(unsigned u) { return __uint_as_float(u & 0xffff0000u); }
__device__ __forceinline__ void unpack8(const u32x4 v, float* f) {
  f[0] = bf_lo(v.x); f[1] = bf_hi(v.x); f[2] = bf_lo(v.y); f[3] = bf_hi(v.y); f[4] = bf_lo(v.z); f[5] = bf_hi(v.z); f[6] = bf_lo(v.w); f[7] = bf_hi(v.w);
}
__device__ __forceinline__ int opaque_v(int v) { asm volatile("" : "+v"(v)); return v; }
__device__ __forceinline__ float fast_sigmoid(float z) { return __builtin_amdgcn_rcpf(1.0f + __builtin_amdgcn_exp2f(-LOG2E * z)); }
__device__ __forceinline__ float act_apply(int act, float v) {
  if (act == 1) { const float u = 1.5957691216057308f * (v + 0.044715f * v * v * v); return v * fast_sigmoid(u); }
  if (act == 2) return v * fast_sigmoid(v);
  if (act == 3) return fast_sigmoid(v);
  if (act == 4) return v * C2;
  return v;
}

__device__ __forceinline__ float row_sumsq(const float* st_row) { return (st_row[0] + st_row[8]) + (st_row[16] + st_row[24]); }
__device__ __forceinline__ float row_rstd(const float* st_row) { return __builtin_amdgcn_rsqf(row_sumsq(st_row) * (1.0f / D) + EPS); }

namespace pg8 {
#ifndef WGM_SEL
#define WGM_SEL 4
#endif
constexpr int BM = 256, BK = 64, HALF = 128, HTB = HALF * BK * 2, STAGE_BYTES = 8 * HTB, NXCD = 8, WGM = WGM_SEL;
__host__ __device__ __forceinline__ int lds_byte(int r, int c) { const int st = (r >> 4) * 2 + (c >> 5), rr = r & 15, cc = c & 31, ob = rr * 64 + cc * 2; return st * 1024 + (ob ^ (((ob >> 9) & 1) << 5)); }
__host__ __device__ __forceinline__ void stage_rc(int b, int& R, int& C) { const int st = b / 1024, sb = b % 1024, swz = sb ^ (((sb >> 9) & 1) << 5); R = (st >> 1) * 16 + swz / 64; C = (st & 1) * 32 + (swz % 64) / 2; }
__host__ __device__ __forceinline__ int perm32(int rho) { const int n = rho >> 4, i = rho & 15; return 8 * (i >> 2) + 4 * n + (i & 3); }

struct Unit { int pm, pn, z; size_t a_byte, b_byte; };
struct Gemm { const bf16_t* A; const bf16_t* Bt; int lda, ldb, K; };

struct SchedGrid {
  int nM, nN, nwg, G, c; size_t astep, bstep;
  __device__ void init(int Mr, int N, int G_, int c_, int lda, int ldb) { nM = Mr / BM; nN = N / BM; nwg = nM * nN; G = G_; c = c_; astep = (size_t)BM * lda * 2; bstep = (size_t)BM * ldb * 2; }
  __device__ bool next(int i, Unit& u) const {
    const long L = (long)i * G + c; if (L >= nwg) return false;
    int wgid = (int)L; { const int q = nwg / NXCD, r = nwg % NXCD, xcd = wgid % NXCD, off = wgid / NXCD; wgid = (xcd < r ? xcd * (q + 1) : r * (q + 1) + (xcd - r) * q) + off; }
    const int nig = WGM * nN, gid = wgid / nig, fm = gid * WGM, gsz = (nM - fm) < WGM ? (nM - fm) : WGM;
    u.pm = fm + ((wgid % nig) % gsz); u.pn = (wgid % nig) / gsz; u.z = 0; u.a_byte = (size_t)u.pm * astep; u.b_byte = (size_t)u.pn * bstep; return true;
  }
};
struct SchedPB {
  int vc;
  __device__ bool next(int i, Unit& u) const {
    if (i >= 8) return false; const int xq = vc & 7, jq = vc >> 3; const int pm = xq * 16 + (jq >> 1), pn = 2 * (jq & 1) + (i & 1), n = i >> 1;
    u.pm = pm; u.pn = pn; u.z = n; u.a_byte = ((size_t)pm * 256 * 1024 + (size_t)n * 256) * 2; u.b_byte = ((size_t)(n * 1024 + pn * 256) * 256) * 2; return true;
  }
};
struct SchedL {
  int vc;
  __device__ bool next(int i, Unit& u) const {
    if (i >= 8) return false; const int xq = vc & 7, jq = vc >> 3; const int pm = xq * 16 + (jq >> 1), pn = 8 * (jq & 1) + i;
    u.pm = pm; u.pn = pn; u.z = 0; u.a_byte = (size_t)pm * 256 * 1024 * 2; u.b_byte = (size_t)pn * 256 * 1024 * 2; return true;
  }
};

constexpr int RSTD_OFF = STAGE_BYTES + 6144;
struct RstdLds {
  const float* stats; LAS unsigned char* lds;
  __device__ __forceinline__ void request(const Unit* nx, int tid, float (&q)[4]) const {
    if (nx && tid < 256) { const GAS float* st = (const GAS float*)stats + (size_t)(nx->pm * BM + tid) * SROW; q[0] = st[0]; q[1] = st[8]; q[2] = st[16]; q[3] = st[24]; }
  }
  __device__ __forceinline__ void park(const Unit* nx, int par_next, int tid, const float (&q)[4]) const {
    if (nx && tid < 256) ((LAS float*)(lds + RSTD_OFF))[par_next * 256 + tid] = __builtin_amdgcn_rsqf(((q[0] + q[1]) + (q[2] + q[3])) * (1.0f / D) + EPS);
  }
  __device__ __forceinline__ void prime(const Unit& u, int par, int tid) const {
    if (tid < 256) { const GAS float* st = (const GAS float*)stats + (size_t)(u.pm * BM + tid) * SROW; ((LAS float*)(lds + RSTD_OFF))[par * 256 + tid] = __builtin_amdgcn_rsqf(((st[0] + st[8]) + (st[16] + st[24])) * (1.0f / D) + EPS); }
  }
  __device__ __forceinline__ float get(int par, int rl) const { return ((const LAS float*)(lds + RSTD_OFF))[par * 256 + rl]; }
};
struct Epi1 {
  static constexpr bool PERM = true;
  bf16_t* O; RstdLds R;
  __device__ __forceinline__ void pre(const Unit& u, int par, int tid) const { R.prime(u, par, tid); }
  __device__ __forceinline__ void operator()(const f32x4 (&acc)[2][2][4][2], const Unit& u, int wr, int wc, int fr, int fq, int par, bool has_nx, const Unit& nx) const {
    const int tid_ = (wr * 4 + wc) * 64 + fq * 16 + fr;
    const int pn = u.pn;
    const int act = (pn <= 1) ? 1 : (pn == 2 || pn == 6 || pn == 10 || pn == 13) ? 2 : (pn == 12) ? 3 : (pn == 3) ? 4 : 0;
    const int row0 = u.pm * BM + wr * 64 + fr; const int col0 = pn * BM + wc * 32 + 8 * fq;
#pragma unroll
    for (int ai = 0; ai < 2; ++ai)
#pragma unroll
      for (int m = 0; m < 4; ++m) {
        const int row = row0 + ai * HALF + m * 16;
        const float rs = R.get(par, ai * HALF + wr * 64 + m * 16 + fr);
        bf16_t* rowp = O + (size_t)row * NP + col0;
#pragma unroll
        for (int bj = 0; bj < 2; ++bj) {
          f32x4 v0 = acc[ai][bj][m][0] * rs, v1 = acc[ai][bj][m][1] * rs;
          if (act != 0) {
#pragma unroll
            for (int j = 0; j < 4; ++j) { v0[j] = act_apply(act, v0[j]); v1[j] = act_apply(act, v1[j]); }
          }
          u32x4 w; w.x = pk_bf16(v0[0], v0[1]); w.y = pk_bf16(v0[2], v0[3]); w.z = pk_bf16(v1[0], v1[1]); w.w = pk_bf16(v1[2], v1[3]);
          *(u32x4*)(rowp + bj * HALF) = w;
        }
      }
    if (has_nx) R.prime(nx, par ^ 1, tid_);
  }
};
struct Epi3a {
  static constexpr bool PERM = true;
  bf16_t* O;
  __device__ __forceinline__ void pre(const Unit&, int, int) const {}
  __device__ __forceinline__ void operator()(const f32x4 (&acc)[2][2][4][2], const Unit& u, int wr, int wc, int fr, int fq, int, bool, const Unit&) const {
    const int row0 = u.pm * BM + wr * 64 + fr; const int col0 = u.z * 1024 + u.pn * BM + wc * 32 + 8 * fq;
#pragma unroll
    for (int ai = 0; ai < 2; ++ai)
#pragma unroll
      for (int m = 0; m < 4; ++m) {
        bf16_t* rowp = O + (size_t)(row0 + ai * HALF + m * 16) * 4096 + col0;
#pragma unroll
        for (int bj = 0; bj < 2; ++bj) {
          const f32x4 v0 = acc[ai][bj][m][0], v1 = acc[ai][bj][m][1];
          u32x4 w; w.x = pk_bf16(v0[0], v0[1]); w.y = pk_bf16(v0[2], v0[3]); w.z = pk_bf16(v1[0], v1[1]); w.w = pk_bf16(v1[2], v1[3]);
          *(u32x4*)(rowp + bj * HALF) = w;
        }
      }
  }
};
struct Epi3b {
  static constexpr bool PERM = false;
  const bf16_t* P; bf16_t* O; RstdLds R;
  __device__ __forceinline__ void pre(const Unit& u, int par, int tid) const { R.prime(u, par, tid); }
  __device__ __forceinline__ void operator()(const f32x4 (&acc)[2][2][4][2], const Unit& u, int wr, int wc, int fr, int fq, int par, bool has_nx, const Unit& nx) const {
    const int tid_ = (wr * 4 + wc) * 64 + fq * 16 + fr;
    const int row0 = u.pm * BM + wr * 64 + fr; const int d0 = u.pn * 64 + wc * 16 + 4 * fq;
    u32x2 np[4];
#define E3_LOAD(g_) do { const GAS bf16_t* pr_ = (const GAS bf16_t*)P + (size_t)(row0 + ((g_) >> 2) * HALF + ((g_) & 3) * 16) * 4096 + d0; \
      _Pragma("unroll") for (int br_ = 0; br_ < 4; ++br_) np[br_] = *(const GAS u32x2*)(pr_ + br_ * 1024); } while (0)
    E3_LOAD(0);
#pragma unroll
    for (int ai = 0; ai < 2; ++ai)
#pragma unroll
      for (int m = 0; m < 4; ++m) {
        const int row = row0 + ai * HALF + m * 16;
        const float rsn = -LOG2E * R.get(par, ai * HALF + wr * 64 + m * 16 + fr);
        u32x2 cp[4];
#pragma unroll
        for (int br = 0; br < 4; ++br) cp[br] = np[br];
        if (ai * 4 + m + 1 < 8) E3_LOAD(ai * 4 + m + 1);
        f32x4 sum = {0.f, 0.f, 0.f, 0.f};
#pragma unroll
        for (int bj = 0; bj < 2; ++bj)
#pragma unroll
          for (int n = 0; n < 2; ++n) {
            const u32x2 pv = cp[2 * bj + n];
            const f32x4 a = acc[ai][bj][m][n] * rsn;
            sum[0] += __builtin_amdgcn_rcpf(1.0f + __builtin_amdgcn_exp2f(a[0])) * bf_lo(pv.x); sum[1] += __builtin_amdgcn_rcpf(1.0f + __builtin_amdgcn_exp2f(a[1])) * bf_hi(pv.x);
            sum[2] += __builtin_amdgcn_rcpf(1.0f + __builtin_amdgcn_exp2f(a[2])) * bf_lo(pv.y); sum[3] += __builtin_amdgcn_rcpf(1.0f + __builtin_amdgcn_exp2f(a[3])) * bf_hi(pv.y);
          }
        u32x2 w; w.x = pk_bf16(sum[0], sum[1]); w.y = pk_bf16(sum[2], sum[3]);
        *(u32x2*)(O + (size_t)row * 1024 + d0) = w;
      }
#undef E3_LOAD
    if (has_nx) R.prime(nx, par ^ 1, tid_);
  }
};
template <bool WITH_NEXT> struct Epi4 {
  static constexpr bool PERM = true;
  const float* base; const bf16_t* baseb; bf16_t* xb; float* stn; const float* wf; LAS unsigned char* lds;
  __device__ __forceinline__ void pre(const Unit&, int, int) const {}
  __device__ __forceinline__ void operator()(const f32x4 (&acc)[2][2][4][2], const Unit& u, int wr, int wc, int fr, int fq, int, bool, const Unit&) const {
    LAS float* redF = (LAS float*)(lds + 3 * HTB);
    LAS float* redS = (LAS float*)(lds + STAGE_BYTES + 1024);
    const int row0 = u.pm * BM + wr * 64 + fr; const int col0 = u.pn * BM + wc * 32 + 8 * fq;
    constexpr int RD = WITH_NEXT ? 1 : 4;
    u32x4 ring[RD][WITH_NEXT ? 4 : 2];
#define E4_LOAD(g_) do { const int row_ = row0 + ((g_) >> 2) * HALF + ((g_) & 3) * 16; const size_t off_ = (size_t)row_ * D + col0; \
      _Pragma("unroll") for (int bj_ = 0; bj_ < 2; ++bj_) { \
        if constexpr (WITH_NEXT) { ring[0][2 * bj_] = __builtin_nontemporal_load((const u32x4*)(base + off_ + bj_ * HALF)); ring[0][2 * bj_ + 1] = __builtin_nontemporal_load((const u32x4*)(base + off_ + bj_ * HALF + 4)); } \
        else ring[(g_) % RD][bj_] = __builtin_nontemporal_load((const u32x4*)(baseb + off_ + bj_ * HALF)); } } while (0)
#pragma unroll
    for (int g0 = 0; g0 < RD; ++g0) E4_LOAD(g0);
#pragma unroll
    for (int ai = 0; ai < 2; ++ai)
#pragma unroll
      for (int m = 0; m < 4; ++m) {
        const int row = row0 + ai * HALF + m * 16; const size_t off = (size_t)row * D + col0;
        float ss = 0.f, f0 = 0.f, f1 = 0.f, f2 = 0.f, f3 = 0.f;
        f32x4 cb[4];
        if constexpr (WITH_NEXT) {
#pragma unroll
          for (int q = 0; q < 4; ++q) cb[q] = __builtin_bit_cast(f32x4, ring[0][q]);
        } else {
#pragma unroll
          for (int bj = 0; bj < 2; ++bj) { const u32x4 w_ = ring[(ai * 4 + m) % RD][bj]; cb[2 * bj] = (f32x4){bf_lo(w_.x), bf_hi(w_.x), bf_lo(w_.y), bf_hi(w_.y)}; cb[2 * bj + 1] = (f32x4){bf_lo(w_.z), bf_hi(w_.z), bf_lo(w_.w), bf_hi(w_.w)}; }
        }
        if (ai * 4 + m + RD < 8) E4_LOAD(ai * 4 + m + RD);
#pragma unroll
        for (int bj = 0; bj < 2; ++bj) {
          const f32x4 x0 = cb[2 * bj] + acc[ai][bj][m][0], x1 = cb[2 * bj + 1] + acc[ai][bj][m][1];
          ss += ((x0[0] * x0[0] + x0[1] * x0[1]) + (x0[2] * x0[2] + x0[3] * x0[3])) + ((x1[0] * x1[0] + x1[1] * x1[1]) + (x1[2] * x1[2] + x1[3] * x1[3]));
          { u32x4 w; w.x = pk_bf16(x0[0], x0[1]); w.y = pk_bf16(x0[2], x0[3]); w.z = pk_bf16(x1[0], x1[1]); w.w = pk_bf16(x1[2], x1[3]); *(u32x4*)(xb + off + bj * HALF) = w; }
          if (WITH_NEXT) {
#pragma unroll
            for (int j = 0; j < 4; ++j) { const f32x4 wv = *(const f32x4*)(wf + (size_t)(col0 + bj * HALF + j) * 4); f0 += x0[j] * wv[0]; f1 += x0[j] * wv[1]; f2 += x0[j] * wv[2]; f3 += x0[j] * wv[3]; }
#pragma unroll
            for (int j = 0; j < 4; ++j) { const f32x4 wv = *(const f32x4*)(wf + (size_t)(col0 + bj * HALF + 4 + j) * 4); f0 += x1[j] * wv[0]; f1 += x1[j] * wv[1]; f2 += x1[j] * wv[2]; f3 += x1[j] * wv[3]; }
          }
        }
        ss += __shfl_xor(ss, 16); ss += __shfl_xor(ss, 32);
        if (WITH_NEXT) { f0 += __shfl_xor(f0, 16); f0 += __shfl_xor(f0, 32); f1 += __shfl_xor(f1, 16); f1 += __shfl_xor(f1, 32);
                         f2 += __shfl_xor(f2, 16); f2 += __shfl_xor(f2, 32); f3 += __shfl_xor(f3, 16); f3 += __shfl_xor(f3, 32); }
        if (fq == 0) {
          const int rl = ai * HALF + wr * 64 + m * 16 + fr;
          redS[wc * 256 + rl] = ss;
          if (WITH_NEXT) { redF[(0 * 4 + wc) * 256 + rl] = f0; redF[(1 * 4 + wc) * 256 + rl] = f1; redF[(2 * 4 + wc) * 256 + rl] = f2; redF[(3 * 4 + wc) * 256 + rl] = f3; }
        }
      }
#undef E4_LOAD
    asm volatile("s_waitcnt lgkmcnt(0)" ::: "memory"); __builtin_amdgcn_s_barrier(); asm volatile("" ::: "memory");
    {
      const int t = (wr * 4 + wc) * 64 + fq * 16 + fr; const int rl = t & 255, part = t >> 8;
      float* dst = stn + ((size_t)(u.pm * BM + rl) * 4 + u.pn) * 8;
      if (part == 0) {
        dst[0] = (redS[rl] + redS[256 + rl]) + (redS[512 + rl] + redS[768 + rl]);
        if (WITH_NEXT) { dst[1] = (redF[rl] + redF[256 + rl]) + (redF[512 + rl] + redF[768 + rl]);
                         dst[2] = (redF[1024 + rl] + redF[1280 + rl]) + (redF[1536 + rl] + redF[1792 + rl]); }
      } else if (WITH_NEXT) {
        dst[3] = (redF[2048 + rl] + redF[2304 + rl]) + (redF[2560 + rl] + redF[2816 + rl]);
        dst[4] = (redF[3072 + rl] + redF[3328 + rl]) + (redF[3584 + rl] + redF[3840 + rl]);
      }
    }
    asm volatile("s_waitcnt lgkmcnt(0)" ::: "memory"); __builtin_amdgcn_s_barrier(); asm volatile("" ::: "memory");
  }
};

template <class Epi, class Sched, bool ALIGN_EPI = true>
__device__ __forceinline__ void gemm_phase(LAS unsigned char* lds, const Gemm g, const Sched& S, const Epi& E) {
  const int tid = opaque_v((int)threadIdx.x), wid = __builtin_amdgcn_readfirstlane(tid >> 6), lane = tid & 63, wr = wid >> 2, wc = wid & 3, fr = lane & 15, fq = lane >> 4;
  const int K = g.K, nt = K / BK;
  unsigned voffA[2], voffB[2];
#pragma unroll
  for (int i = 0; i < 2; ++i) { int R, C; stage_rc(tid * 16 + i * 8192, R, C); const int Rb = Epi::PERM ? ((R & ~31) + perm32(R & 31)) : R;
    voffA[i] = (unsigned)(R * g.lda + C) * 2u; voffB[i] = (unsigned)(Rb * g.ldb + C) * 2u; }
  const size_t kstep = (size_t)(BK * 2);
  const size_t hstepA = (size_t)HALF * g.lda * 2, hstepB = (size_t)HALF * g.ldb * 2;
  const unsigned ldsw = (unsigned)wid * 1024u;
  const int aoff = lds_byte(wr * 64 + fr, fq * 8), boff = lds_byte(wc * 32 + fr, fq * 8);
#define PG8_SA(b, h) (((b) * 2 + (h)) * HTB)
#define PG8_SB(b, h) ((4 + (b) * 2 + (h)) * HTB)
#define PG8_STAGE(bufoff, gbase, voff) do { _Pragma("unroll") for (int _i = 0; _i < 2; ++_i) \
    __builtin_amdgcn_global_load_lds((const unsigned*)((const char*)(gbase) + (voff)[_i]), (LAS unsigned*)(lds + (bufoff) + ldsw + _i * 8192), 16, 0, 0); } while (0)
#define PG8_LDA(dst, b, h) do { _Pragma("unroll") for (int m = 0; m < 4; ++m) _Pragma("unroll") for (int k = 0; k < 2; ++k) dst[m][k] = *(const LAS bf16x8*)(lds + PG8_SA(b, h) + aoff + m * 2048 + k * 1024); } while (0)
#define PG8_LDB(dst, b, h) do { _Pragma("unroll") for (int n = 0; n < 2; ++n) _Pragma("unroll") for (int k = 0; k < 2; ++k) dst[n][k] = *(const LAS bf16x8*)(lds + PG8_SB(b, h) + boff + n * 2048 + k * 1024); } while (0)
#define PG8_MMA(ai, bj, At, Bt) do { __builtin_amdgcn_s_setprio(1); _Pragma("unroll") for (int m = 0; m < 4; ++m) _Pragma("unroll") for (int n = 0; n < 2; ++n) _Pragma("unroll") for (int k = 0; k < 2; ++k) \
    acc[ai][bj][m][n] = __builtin_amdgcn_mfma_f32_16x16x32_bf16(Bt[n][k], At[m][k], acc[ai][bj][m][n], 0, 0, 0); __builtin_amdgcn_s_setprio(0); } while (0)
#define PG8_WAIT_V(n) asm volatile("s_waitcnt vmcnt(" #n ")" ::: "memory")
#define PG8_WAIT_L(n) asm volatile("s_waitcnt lgkmcnt(" #n ")" ::: "memory")
#define PG8_BAR __builtin_amdgcn_s_barrier()
#define PG8_SCHED __builtin_amdgcn_sched_barrier(0)
  Unit cur, nxt; int ui = 0;
  if (!S.next(0, cur)) return;
  E.pre(cur, 0, tid);
  f32x4 acc[2][2][4][2];
#pragma unroll
  for (int a = 0; a < 2; ++a)
#pragma unroll
    for (int b = 0; b < 2; ++b)
#pragma unroll
      for (int m = 0; m < 4; ++m)
#pragma unroll
        for (int n = 0; n < 2; ++n) acc[a][b][m][n] = (f32x4){0.f, 0.f, 0.f, 0.f};
  bf16x8 At[4][2], B0[2][2], B1[2][2];
  const char* cA = (const char*)g.A + cur.a_byte; const char* cB = (const char*)g.Bt + cur.b_byte;
  PG8_STAGE(PG8_SB(0, 0), cB, voffB); PG8_STAGE(PG8_SB(0, 1), cB + hstepB, voffB); PG8_STAGE(PG8_SA(0, 0), cA, voffA); PG8_STAGE(PG8_SA(0, 1), cA + hstepA, voffA);
  if (wr == 1) PG8_BAR;
  PG8_WAIT_V(2); PG8_BAR;
  PG8_STAGE(PG8_SB(1, 0), cB + kstep, voffB); PG8_STAGE(PG8_SA(1, 0), cA + kstep, voffA); PG8_STAGE(PG8_SB(1, 1), cB + hstepB + kstep, voffB);
  PG8_WAIT_V(6); PG8_BAR;
  for (;;) {
    const bool has_next = S.next(ui + 1, nxt);
    const char* nA = has_next ? (const char*)g.A + nxt.a_byte : cA; const char* nB = has_next ? (const char*)g.Bt + nxt.b_byte : cB;
#pragma unroll 1
    for (int t = 0; t < nt; t += 2) {
      const bool last = (t == nt - 2);
      const char* a1 = cA + (size_t)(t + 1) * kstep;
      const char* a2 = last ? nA : cA + (size_t)(t + 2) * kstep; const char* b2 = last ? nB : cB + (size_t)(t + 2) * kstep;
      const char* a3 = a2 + kstep; const char* b3 = b2 + kstep;
      PG8_LDB(B0, 0, 0); PG8_LDB(B1, 0, 1); PG8_SCHED; PG8_LDA(At, 0, 0); PG8_STAGE(PG8_SA(1, 1), a1 + hstepA, voffA);
      PG8_WAIT_V(8); PG8_WAIT_L(0); PG8_BAR; PG8_MMA(0, 0, At, B0); PG8_MMA(0, 1, At, B1); PG8_BAR; PG8_SCHED;
      PG8_LDA(At, 0, 1); PG8_STAGE(PG8_SB(0, 0), b2, voffB); PG8_STAGE(PG8_SB(0, 1), b2 + hstepB, voffB); PG8_STAGE(PG8_SA(0, 0), a2, voffA);
      PG8_WAIT_V(8); PG8_WAIT_L(0); PG8_BAR; PG8_MMA(1, 0, At, B0); PG8_MMA(1, 1, At, B1); PG8_BAR; PG8_SCHED;
      PG8_LDB(B0, 1, 0); PG8_LDB(B1, 1, 1); PG8_SCHED; PG8_LDA(At, 1, 0); PG8_STAGE(PG8_SA(0, 1), a2 + hstepA, voffA);
      PG8_WAIT_V(8); PG8_WAIT_L(0); PG8_BAR; PG8_MMA(0, 0, At, B0); PG8_MMA(0, 1, At, B1); PG8_BAR; PG8_SCHED;
      PG8_LDA(At, 1, 1); PG8_STAGE(PG8_SB(1, 0), b3, voffB); PG8_STAGE(PG8_SB(1, 1), b3 + hstepB, voffB); PG8_STAGE(PG8_SA(1, 0), a3, voffA);
      PG8_WAIT_V(8); PG8_WAIT_L(0); PG8_BAR; PG8_MMA(1, 0, At, B0); PG8_MMA(1, 1, At, B1); PG8_BAR; PG8_SCHED;
    }
    if constexpr (ALIGN_EPI) { if (wr == 0) PG8_BAR; }
    E(acc, cur, wr, wc, fr, fq, ui & 1, has_next, nxt);
    if (!has_next) break;
#pragma unroll
    for (int a = 0; a < 2; ++a)
#pragma unroll
      for (int b = 0; b < 2; ++b)
#pragma unroll
        for (int m = 0; m < 4; ++m)
#pragma unroll
          for (int n = 0; n < 2; ++n) acc[a][b][m][n] = (f32x4){0.f, 0.f, 0.f, 0.f};
    cur = nxt; cA = nA; cB = nB; ++ui;
    if constexpr (ALIGN_EPI) { if (wr == 1) PG8_BAR; }
  }
  PG8_WAIT_V(0);
  if constexpr (!ALIGN_EPI) { if (wr == 0) PG8_BAR; }
  PG8_BAR;
#undef PG8_SA
#undef PG8_SB
#undef PG8_STAGE
#undef PG8_LDA
#undef PG8_LDB
#undef PG8_MMA
#undef PG8_WAIT_V
#undef PG8_WAIT_L
#undef PG8_BAR
#undef PG8_SCHED
}
}

__device__ __forceinline__ float wave_sum(float v) {
#pragma unroll
  for (int o = 1; o < 64; o <<= 1) v += __shfl_xor(v, o);
  return v;
}
__device__ __forceinline__ void transpose_item(const float* __restrict__ W, int ldw, int srccol, const float* __restrict__ gs, bf16_t* __restrict__ WT, int K, int k0, int n0,
                                               LAS float* scr, int lane) {
  float tv[32];
#pragma unroll
  for (int i = 0; i < 32; ++i) { const int kk = 2 * i + (lane >> 5); tv[i] = __builtin_nontemporal_load(&W[(size_t)(k0 + kk) * ldw + srccol]); }
  if (gs) {
#pragma unroll
    for (int i = 0; i < 32; ++i) tv[i] *= gs[k0 + 2 * i + (lane >> 5)];
  }
#pragma unroll
  for (int i = 0; i < 32; ++i) { const int kk = 2 * i + (lane >> 5); scr[kk * 33 + (lane & 31)] = tv[i]; }
  asm volatile("s_waitcnt lgkmcnt(0)" ::: "memory");
  const int c = lane & 7;
#pragma unroll
  for (int j = 0; j < 4; ++j) { const int n = (lane >> 3) + 8 * j; const LAS float* s = scr + (8 * c) * 33 + n;
    u32x4 o; o.x = pk_bf16(s[0 * 33], s[1 * 33]); o.y = pk_bf16(s[2 * 33], s[3 * 33]); o.z = pk_bf16(s[4 * 33], s[5 * 33]); o.w = pk_bf16(s[6 * 33], s[7 * 33]);
    *(u32x4*)(WT + (size_t)(n0 + n) * K + k0 + 8 * c) = o; }
  asm volatile("s_waitcnt lgkmcnt(0)" ::: "memory");
}

struct Params {
  const float *x, *norm_g, *w_in, *f_bias, *sgu_w, *sgu_b, *sgu_ln_g, *sgu_ln_b, *short_conv_w, *conf_dw_w, *conf_dw_b, *conf_ln_g, *conf_ln_b, *w_branch, *w_out, *final_g;
  float* out; unsigned char* ws;
};

constexpr int I_W1 = 16 * 112, I_WM = 16 * 128, I_WB = 4 * 4 * 32, I_WO = 16 * 32, I_L = I_W1 + I_WM + I_WB + I_WO;
__device__ __forceinline__ void weight_item(const Params& p, int l, int r, LAS float* scr, int lane) {
  unsigned char* ws = p.ws;
  const float* gl = p.norm_g + l * D;
  const float* win = p.w_in + (size_t)l * D * INC;
  if (r < I_W1) { const int kb = r / 112, nb = r % 112, n0 = 32 * nb; const int n = n0 + (lane & 31); const int col = n < 1536 ? n : n + 4;
    transpose_item(win, INC, col, gl, (bf16_t*)(ws + WS_W1T) + (size_t)l * NP * D, D, 64 * kb, n0, scr, lane); return; }
  r -= I_W1;
  if (r < I_WM) { const int kb = r / 128, nb = r % 128, n0 = 32 * nb; const int c = (n0 & 255) + (lane & 31), pnn = n0 >> 8;
    const int bj = c >> 7, wc = (c >> 5) & 3, n = (c >> 4) & 1, low = c & 15; const int col = 3588 + (2 * bj + n) * 1024 + 64 * pnn + 16 * wc + low;
    transpose_item(win, INC, col, gl, (bf16_t*)(ws + WS_WMT) + (size_t)l * 4096 * D, D, 64 * kb, n0, scr, lane); return; }
  r -= I_WM;
  if (r < I_WB) { const int br = r / 128, q = r % 128, kb = q / 32, nb = q % 32, n0 = 32 * nb;
    transpose_item(p.w_branch + ((size_t)l * 4 + br) * 256 * D, D, n0 + (lane & 31), nullptr, (bf16_t*)(ws + WS_WBT) + ((size_t)l * 4 + br) * D * 256, 256, 64 * kb, n0, scr, lane); return; }
  r -= I_WB;
  { const int kb = r / 32, nb = r % 32, n0 = 32 * nb;
    transpose_item(p.w_out + (size_t)l * D * D, D, n0 + (lane & 31), nullptr, (bf16_t*)(ws + WS_WOT) + (size_t)l * D * D, D, 64 * kb, n0, scr, lane); }
}

__device__ __forceinline__ void p0_prologue(const Params& p, LAS unsigned char* lds, int tid, int lane, int wid, int G, int bx) {
  unsigned char* ws = p.ws;
  LAS float* scr = (LAS float*)(lds + wid * 16384);
  const int gw = bx * 8 + wid, NGW = G * 8;
  for (int it = gw; it < I_L; it += NGW) weight_item(p, 0, it, scr, lane);
  const int gt = bx * 512 + tid, GT = G * 512;
  for (int i = gt; i < 2 * D * 4; i += GT) { const int l = i / (D * 4), k = (i >> 2) & (D - 1), h = i & 3;
    ((float*)(ws + WS_WF))[i] = p.norm_g[l * D + k] * p.w_in[((size_t)l * D + k) * INC + 1536 + h]; }
  for (int i = gt; i < 2 * 4 * 128 * 128; i += GT) { const int s = i & 127, t = (i >> 7) & 127; const float v = (s <= t) ? p.sgu_w[i] : 0.f;
    ((bf16_t*)(ws + WS_SGUW))[i] = (bf16_t)(pk_bf16(v, 0.f) & 0xffffu); }
  {
    f32x4 wv[16];
#pragma unroll
    for (int j = 0; j < 4; ++j)
#pragma unroll
      for (int e = 0; e < 4; ++e) { const int k = 256 * j + 4 * lane + e; const f32x4 w4 = *(const f32x4*)(p.w_in + (size_t)k * INC + 1536); wv[4 * j + e] = w4 * p.norm_g[k]; }
    float* stats = (float*)(ws + WS_STATS);
    bf16_t* xb = (bf16_t*)(ws + WS_XB);
    for (int mm = gw; mm < M; mm += 2 * NGW) {
      const int m2 = mm + NGW; const bool has2 = m2 < M;
      f32x4 va[4], vb[4];
      { const f32x4* xr = (const f32x4*)(p.x + (size_t)mm * D) + lane;
#pragma unroll
        for (int j = 0; j < 4; ++j) va[j] = __builtin_nontemporal_load(&xr[64 * j]); }
      if (has2) { const f32x4* xr = (const f32x4*)(p.x + (size_t)m2 * D) + lane;
#pragma unroll
        for (int j = 0; j < 4; ++j) vb[j] = __builtin_nontemporal_load(&xr[64 * j]); }
      else {
#pragma unroll
        for (int j = 0; j < 4; ++j) vb[j] = (f32x4){0.f, 0.f, 0.f, 0.f}; }
#pragma unroll
      for (int rr = 0; rr < 2; ++rr) {
        const int m = rr == 0 ? mm : m2;
        if (rr == 1 && !has2) break;
        float ss = 0.f, f0 = 0.f, f1 = 0.f, f2 = 0.f, f3 = 0.f;
        u32x2* o8 = (u32x2*)(xb + (size_t)m * D) + lane;
#pragma unroll
        for (int j = 0; j < 4; ++j) { const f32x4 v = rr == 0 ? va[j] : vb[j];
          ss += (v[0] * v[0] + v[1] * v[1]) + (v[2] * v[2] + v[3] * v[3]);
#pragma unroll
          for (int e = 0; e < 4; ++e) { const f32x4 w4 = wv[4 * j + e]; f0 += v[e] * w4[0]; f1 += v[e] * w4[1]; f2 += v[e] * w4[2]; f3 += v[e] * w4[3]; }
          u32x2 w; w.x = pk_bf16(v[0], v[1]); w.y = pk_bf16(v[2], v[3]); o8[64 * j] = w; }
        ss = wave_sum(ss); f0 = wave_sum(f0); f1 = wave_sum(f1); f2 = wave_sum(f2); f3 = wave_sum(f3);
        if (lane < SROW) { const float v = lane == 0 ? ss : lane == 1 ? f0 : lane == 2 ? f1 : lane == 3 ? f2 : lane == 4 ? f3 : 0.f; stats[(size_t)m * SROW + lane] = v; }
      }
    }
  }
}

__device__ __forceinline__ void conv_c(const bf16_t* __restrict__ proj, bf16_t* __restrict__ Y, const float* __restrict__ w, int m0, int tid, int pass0) {
  const int c8 = (tid & 31) * 8, rs = tid >> 5;
  float w0[8], w1[8], w2[8];
#pragma unroll
  for (int e = 0; e < 8; ++e) { w0[e] = w[c8 + e]; w1[e] = w[256 + c8 + e]; w2[e] = w[512 + c8 + e]; }
#pragma unroll 4
  for (int pq = 0; pq < 4; ++pq) {
    const int pass = pass0 + pq;
    const int m = m0 + pass * 16 + rs; const int s = m & (SEQ - 1);
    const bf16_t* row = proj + (size_t)m * NP;
    const u32x4 Bv = *(const u32x4*)(row + PC_CB + c8), Gv = *(const u32x4*)(row + PC_CG + c8);
    const u32x4 Cc0 = *(const u32x4*)(row + PC_CC + c8), Xx0 = *(const u32x4*)(row + PC_CX + c8);
    u32x4 Cc1 = {0, 0, 0, 0}, Xx1 = {0, 0, 0, 0}, Cc2 = {0, 0, 0, 0}, Xx2 = {0, 0, 0, 0};
    if (s >= 1) { Cc1 = *(const u32x4*)(row - NP + PC_CC + c8); Xx1 = *(const u32x4*)(row - NP + PC_CX + c8); }
    if (s >= 2) { Cc2 = *(const u32x4*)(row - 2 * NP + PC_CC + c8); Xx2 = *(const u32x4*)(row - 2 * NP + PC_CX + c8); }
    float b[8], g[8], c0[8], x0[8], c1[8], x1[8], c2[8], x2[8], y[8];
    unpack8(Bv, b); unpack8(Gv, g); unpack8(Cc0, c0); unpack8(Xx0, x0); unpack8(Cc1, c1); unpack8(Xx1, x1); unpack8(Cc2, c2); unpack8(Xx2, x2);
#pragma unroll
    for (int e = 0; e < 8; ++e) { const float cv = w0[e] * (c2[e] * x2[e]) + w1[e] * (c1[e] * x1[e]) + w2[e] * (c0[e] * x0[e]); y[e] = b[e] * cv * g[e]; }
    u32x4 o; o.x = pk_bf16(y[0], y[1]); o.y = pk_bf16(y[2], y[3]); o.z = pk_bf16(y[4], y[5]); o.w = pk_bf16(y[6], y[7]);
    *(u32x4*)(Y + (size_t)m * D + 512 + c8) = o;
  }
}

__device__ __forceinline__ void conv_d(LAS unsigned char* lds, const bf16_t* __restrict__ proj, bf16_t* __restrict__ Y, const float* __restrict__ dw, const float* __restrict__ db,
                                       const float* __restrict__ lg, const float* __restrict__ lb, int m0, int tid, int sub0) {
  constexpr int HP = 260, TT = 32, HR = TT + 30;
  LAS float* H = (LAS float*)lds;
  LAS float* YB = (LAS float*)(lds + 65536);
  const int c = tid & 255, tg = tid >> 8;
  float w[31];
#pragma unroll
  for (int k = 0; k < 31; ++k) w[k] = dw[k * 256 + c];
  const float bias = db[c];
  u32x4 ha[4], hs[4];
#define CD_LOAD(mb_) do { const int sb_ = (mb_) & (SEQ - 1); _Pragma("unroll") for (int it = 0; it < 4; ++it) { const int idx = tid + 512 * it; const int j = idx >> 5, c8 = (idx & 31) * 8; \
      ha[it] = (u32x4){0u, 0u, 0u, 0u}; hs[it] = (u32x4){0u, 0u, 0u, 0u}; \
      if (idx < HR * 32 && sb_ + j - 30 >= 0) { const bf16_t* row = proj + (size_t)((mb_) - 30 + j) * NP; ha[it] = *(const u32x4*)(row + PC_DA + c8); hs[it] = *(const u32x4*)(row + PC_DS + c8); } } } while (0)
#define CD_WRITE() do { _Pragma("unroll") for (int it = 0; it < 4; ++it) { const int idx = tid + 512 * it; const int j = idx >> 5, c8 = (idx & 31) * 8; \
      if (idx < HR * 32) { float a[8], sg[8]; unpack8(ha[it], a); unpack8(hs[it], sg); \
        *(LAS f32x4*)(H + j * HP + c8) = (f32x4){a[0] * sg[0], a[1] * sg[1], a[2] * sg[2], a[3] * sg[3]}; *(LAS f32x4*)(H + j * HP + c8 + 4) = (f32x4){a[4] * sg[4], a[5] * sg[5], a[6] * sg[6], a[7] * sg[7]}; } } } while (0)
  CD_LOAD(m0 + sub0 * TT);
#pragma unroll 1
  for (int sub = sub0; sub < sub0 + 2; ++sub) {
    const int mb = m0 + sub * TT;
    CD_WRITE();
    __syncthreads();
    if (sub + 1 < sub0 + 2) CD_LOAD(mb + TT);
    const bf16_t* grow_ = proj + (size_t)(mb + (tid >> 4)) * NP + PC_DG + 16 * (tid & 15);
    const u32x4 gpre0 = *(const u32x4*)(grow_), gpre1 = *(const u32x4*)(grow_ + 8);
#pragma unroll 1
    for (int i = 0; i < 4; ++i) {
      const int tl = tg * 16 + 4 * i;
      float a0 = bias, a1 = bias, a2 = bias, a3 = bias;
#pragma unroll
      for (int k = 0; k < 34; ++k) {
        const float hv = H[(tl + k) * HP + c];
        if (k <= 30) a0 += w[k <= 30 ? k : 0] * hv;
        if (k >= 1 && k <= 31) a1 += w[(k >= 1 && k <= 31) ? k - 1 : 0] * hv;
        if (k >= 2 && k <= 32) a2 += w[(k >= 2 && k <= 32) ? k - 2 : 0] * hv;
        if (k >= 3) a3 += w[k >= 3 ? k - 3 : 0] * hv;
      }
      YB[(tl + 0) * HP + c] = a0; YB[(tl + 1) * HP + c] = a1; YB[(tl + 2) * HP + c] = a2; YB[(tl + 3) * HP + c] = a3;
    }
    __syncthreads();
    {
      const int r = tid >> 4, q = tid & 15; const int m = mb + r;
      f32x4 v[4]; float s1 = 0.f, s2 = 0.f;
#pragma unroll
      for (int e = 0; e < 4; ++e) { v[e] = *(const LAS f32x4*)(YB + r * HP + 16 * q + 4 * e); s1 += (v[e][0] + v[e][1]) + (v[e][2] + v[e][3]);
        s2 += (v[e][0] * v[e][0] + v[e][1] * v[e][1]) + (v[e][2] * v[e][2] + v[e][3] * v[e][3]); }
#pragma unroll
      for (int o = 1; o < 16; o <<= 1) { s1 += __shfl_xor(s1, o); s2 += __shfl_xor(s2, o); }
      const float mu = s1 * (1.0f / 256.0f); const float var = fmaxf(s2 * (1.0f / 256.0f) - mu * mu, 0.f); const float rstd = __builtin_amdgcn_rsqf(var + EPS);
      float gt[16]; unpack8(gpre0, gt); unpack8(gpre1, gt + 8);
      float o[16];
#pragma unroll
      for (int e = 0; e < 4; ++e) { const f32x4 g4 = *(const f32x4*)(lg + 16 * q + 4 * e), b4 = *(const f32x4*)(lb + 16 * q + 4 * e);
#pragma unroll
        for (int j = 0; j < 4; ++j) { const float z = (v[e][j] - mu) * rstd * g4[j] + b4[j]; o[4 * e + j] = z * fast_sigmoid(z) * gt[4 * e + j]; } }
      u32x4 o0, o1; o0.x = pk_bf16(o[0], o[1]); o0.y = pk_bf16(o[2], o[3]); o0.z = pk_bf16(o[4], o[5]); o0.w = pk_bf16(o[6], o[7]);
      o1.x = pk_bf16(o[8], o[9]); o1.y = pk_bf16(o[10], o[11]); o1.z = pk_bf16(o[12], o[13]); o1.w = pk_bf16(o[14], o[15]);
      bf16_t* yo = Y + (size_t)m * D + 768 + 16 * q;
      *(u32x4*)yo = o0; *(u32x4*)(yo + 8) = o1;
    }
    __syncthreads();
  }
#undef CD_LOAD
#undef CD_WRITE
}

__device__ __forceinline__ void gmlp_unit(LAS unsigned char* lds, const bf16_t* __restrict__ proj, bf16_t* __restrict__ Y, const bf16_t* __restrict__ sw  ,
                                          const float* __restrict__ sb  , const float* __restrict__ lg, const float* __restrict__ lb, int m0, int tid) {
  constexpr int VP = 136;
  LAS bf16_t* vnT = (LAS bf16_t*)lds;
  {
    const int r = tid >> 2, q = tid & 3;
    const bf16_t* vrow = proj + (size_t)(m0 + r) * NP + PC_V + 64 * q;
    float v[64]; float s1 = 0.f;
#pragma unroll
    for (int e = 0; e < 8; ++e) { unpack8(*(const u32x4*)(vrow + 8 * e), v + 8 * e); }
#pragma unroll
    for (int e = 0; e < 64; ++e) s1 += v[e];
    s1 += __shfl_xor(s1, 1); s1 += __shfl_xor(s1, 2);
    const float mu = s1 * (1.0f / 256.0f); float s2 = 0.f;
#pragma unroll
    for (int e = 0; e < 64; ++e) { const float d = v[e] - mu; s2 += d * d; }
    s2 += __shfl_xor(s2, 1); s2 += __shfl_xor(s2, 2);
    const float rstd = __builtin_amdgcn_rsqf(s2 * (1.0f / 256.0f) + EPS);
#pragma unroll
    for (int e = 0; e < 64; ++e) { const int ch = 64 * q + e; const float z = (v[e] - mu) * rstd * lg[ch] + lb[ch]; vnT[ch * VP + r] = (bf16_t)(pk_bf16(z, 0.f) & 0xffffu); }
  }
  __syncthreads();
  {
    const int lane = tid & 63, wid = tid >> 6, r32 = lane & 31, hi = lane >> 5; const int h = wid >> 1, th = wid & 1;
    f32x16 acc[2][2];
#pragma unroll
    for (int a = 0; a < 2; ++a)
#pragma unroll
      for (int b = 0; b < 2; ++b)
#pragma unroll
        for (int r = 0; r < 16; ++r) acc[a][b][r] = 0.f;
    const bf16_t* wbase = sw + (size_t)h * 128 * 128 + (size_t)(64 * th + r32) * 128 + 8 * hi;
    const LAS bf16_t* abase = vnT + (64 * h + r32) * VP + 8 * hi;
#pragma unroll
    for (int ks = 0; ks < 8; ++ks) {
      bf16x8 a0 = *(const LAS bf16x8*)(abase + 16 * ks), a1 = *(const LAS bf16x8*)(abase + 32 * VP + 16 * ks);
      bf16x8 b0 = *(const bf16x8*)(wbase + 16 * ks), b1 = *(const bf16x8*)(wbase + 32 * 128 + 16 * ks);
      acc[0][0] = __builtin_amdgcn_mfma_f32_32x32x16_bf16(a0, b0, acc[0][0], 0, 0, 0);
      acc[0][1] = __builtin_amdgcn_mfma_f32_32x32x16_bf16(a0, b1, acc[0][1], 0, 0, 0);
      acc[1][0] = __builtin_amdgcn_mfma_f32_32x32x16_bf16(a1, b0, acc[1][0], 0, 0, 0);
      acc[1][1] = __builtin_amdgcn_mfma_f32_32x32x16_bf16(a1, b1, acc[1][1], 0, 0, 0);
    }
    __syncthreads();
    LAS float* stg = (LAS float*)lds;
#pragma unroll
    for (int tb = 0; tb < 2; ++tb) {
      const int t = 64 * th + 32 * tb + r32; const float bt = sb[h * 128 + t];
#pragma unroll
      for (int db = 0; db < 2; ++db)
#pragma unroll
        for (int g = 0; g < 4; ++g) {
          const int chunk = (64 * h + 32 * db + 8 * g + 4 * hi) >> 2;
          *(LAS f32x4*)(stg + t * 256 + ((chunk ^ (t & 63)) << 2)) = (f32x4){acc[db][tb][4 * g + 0] + bt, acc[db][tb][4 * g + 1] + bt, acc[db][tb][4 * g + 2] + bt, acc[db][tb][4 * g + 3] + bt};
        }
    }
    __syncthreads();
    {
      const int c8 = (tid & 31) * 8, rs = tid >> 5;
#pragma unroll 4
      for (int pass = 0; pass < 8; ++pass) {
        const int t = pass * 16 + rs;
        const bf16_t* prow = proj + (size_t)(m0 + t) * NP;
        float uu[8], gg[8]; unpack8(*(const u32x4*)(prow + PC_U + c8), uu); unpack8(*(const u32x4*)(prow + PC_AG + c8), gg);
        const int ck = c8 >> 2;
        const f32x4 a = *(const LAS f32x4*)(stg + t * 256 + ((ck ^ (t & 63)) << 2)), c = *(const LAS f32x4*)(stg + t * 256 + (((ck + 1) ^ (t & 63)) << 2));
        u32x4 o; o.x = pk_bf16(uu[0] * a[0] * gg[0], uu[1] * a[1] * gg[1]); o.y = pk_bf16(uu[2] * a[2] * gg[2], uu[3] * a[3] * gg[3]);
        o.z = pk_bf16(uu[4] * c[0] * gg[4], uu[5] * c[1] * gg[5]); o.w = pk_bf16(uu[6] * c[2] * gg[6], uu[7] * c[3] * gg[7]);
        *(u32x4*)(Y + (size_t)(m0 + t) * D + c8) = o;
      }
    }
  }
  __syncthreads();
}

constexpr int AT_K = 0, AT_V = 16384, AT_CUM = 40960, AT_WSF = 57344, AT_SCAN = 59392, AT_OST = 61440;
constexpr float SKIP_THR = 100.0f, THRL = 64.0f;
__device__ __forceinline__ int crow(int r, int hi) { return (r & 3) + 8 * (r >> 2) + 4 * hi; }
__device__ __forceinline__ unsigned bf_rne(float v) { return pk_bf16(v, 0.f) & 0xffffu; }
__device__ __forceinline__ bf16x8 split3(float v, bool first, bool active) {
  const unsigned h = bf_rne(v); const float r1 = v - __uint_as_float(h << 16);
  const unsigned m = bf_rne(r1); const float r2 = r1 - __uint_as_float(m << 16);
  const unsigned l = bf_rne(r2);
  const unsigned one = 0x3f80u;
  u32x4 w;
  if (first) { w.x = h | (m << 16); w.y = l | (one << 16); w.z = one | (one << 16); w.w = 0u; }
  else       { w.x = one | (one << 16); w.y = one | (h << 16); w.z = m | (l << 16); w.w = 0u; }
  if (!active) { w.x = 0u; w.y = 0u; w.z = 0u; }
  return __builtin_bit_cast(bf16x8, w);
}

struct AttnState { float mhat, lsum; f32x16 o0, o1; bf16x8 qx; };

struct AttnP { bf16x8 pa[4]; bool resc; };
__device__ __forceinline__ void attn_front(AttnState& S, AttnP& P, const LAS unsigned char* Ks, const LAS float* cum, LAS float* wsf, const bf16x8 (&qr)[4],
                                           float cref, int t, int q0w, int qrow, int r32, int hi) {
  const bf16x8 kx0 = split3(cref - cum[64 * t + r32], true, hi == 0), kx1 = split3(cref - cum[64 * t + 32 + r32], true, hi == 0);
  f32x16 p0, p1;
#pragma unroll
  for (int r = 0; r < 16; ++r) { p0[r] = 0.f; p1[r] = 0.f; }
  p0 = __builtin_amdgcn_mfma_f32_32x32x16_bf16(kx0, S.qx, p0, 0, 0, 0);
  p1 = __builtin_amdgcn_mfma_f32_32x32x16_bf16(kx1, S.qx, p1, 0, 0, 0);
  const LAS unsigned char* kb = Ks + hi * 1024 + r32 * 16;
#pragma unroll
  for (int d0 = 0; d0 < 4; ++d0) {
    const bf16x8 k0 = *(const LAS bf16x8*)(kb + d0 * 2048), k1 = *(const LAS bf16x8*)(kb + d0 * 2048 + 512);
    p0 = __builtin_amdgcn_mfma_f32_32x32x16_bf16(k0, qr[d0], p0, 0, 0, 0);
    p1 = __builtin_amdgcn_mfma_f32_32x32x16_bf16(k1, qr[d0], p1, 0, 0, 0);
  }
  if (64 * t + 63 > q0w) {
#pragma unroll
    for (int r = 0; r < 16; ++r) { const int kv = 64 * t + crow(r, hi); if (kv > qrow) p0[r] = -INFINITY; if (kv + 32 > qrow) p1[r] = -INFINITY; }
  }
  float rm = fmaxf(fmaxf(p0[0], p0[1]), p1[0]);
#pragma unroll
  for (int r = 2; r < 16; r += 2) rm = fmaxf(fmaxf(rm, p0[r]), p0[r + 1]);
#pragma unroll
  for (int r = 1; r < 16; r += 2) rm = fmaxf(fmaxf(rm, p1[r]), p1[(r + 1) & 15]);
  rm = fmaxf(rm, __shfl_xor(rm, 32));
  const bool resc = __any(rm > THRL);
  if (resc) {
    const float dl = fmaxf(rm, 0.f); S.mhat += dl;
#pragma unroll
    for (int r = 0; r < 16; ++r) { p0[r] -= dl; p1[r] -= dl; }
    const float f = __builtin_amdgcn_exp2f(-dl); S.lsum *= f;
    if (hi == 0) wsf[r32] = f;
    S.qx = split3(-S.mhat, false, hi == 0);
  }
  float ps = 0.f;
#pragma unroll
  for (int r = 0; r < 16; ++r) { p0[r] = __builtin_amdgcn_exp2f(p0[r]); p1[r] = __builtin_amdgcn_exp2f(p1[r]); ps += p0[r] + p1[r]; }
  S.lsum += ps;
  { u32x4 w;
    w.x = pk_bf16(p0[0], p0[1]); w.y = pk_bf16(p0[2], p0[3]); w.z = pk_bf16(p0[4], p0[5]); w.w = pk_bf16(p0[6], p0[7]); P.pa[0] = __builtin_bit_cast(bf16x8, w);
    w.x = pk_bf16(p0[8], p0[9]); w.y = pk_bf16(p0[10], p0[11]); w.z = pk_bf16(p0[12], p0[13]); w.w = pk_bf16(p0[14], p0[15]); P.pa[1] = __builtin_bit_cast(bf16x8, w);
    w.x = pk_bf16(p1[0], p1[1]); w.y = pk_bf16(p1[2], p1[3]); w.z = pk_bf16(p1[4], p1[5]); w.w = pk_bf16(p1[6], p1[7]); P.pa[2] = __builtin_bit_cast(bf16x8, w);
    w.x = pk_bf16(p1[8], p1[9]); w.y = pk_bf16(p1[10], p1[11]); w.z = pk_bf16(p1[12], p1[13]); w.w = pk_bf16(p1[14], p1[15]); P.pa[3] = __builtin_bit_cast(bf16x8, w); }
  P.resc = resc;
}

__device__ __forceinline__ void attn_back(AttnState& S, const AttnP& P, const LAS unsigned char* Vs, const LAS float* wsf, int lane, int hi) {
  const bool resc = P.resc;
  if (resc) {
#pragma unroll
    for (int g = 0; g < 4; ++g) { const f32x4 ff = *(const LAS f32x4*)(wsf + 8 * g + 4 * hi);
#pragma unroll
      for (int j = 0; j < 4; ++j) { S.o0[4 * g + j] *= ff[j]; S.o1[4 * g + j] *= ff[j]; } }
  }
  const LAS unsigned char* vb = Vs + ((lane >> 4) & 1) * 32 + (lane & 3) * 8 + (4 * hi + ((lane & 15) >> 2)) * 64;
  s16x4 lo0[4], hh0[4], lo1[4], hh1[4];
#pragma unroll
  for (int ks = 0; ks < 4; ++ks) {
    lo0[ks] = __builtin_bit_cast(s16x4, __builtin_amdgcn_ds_read_tr16_b64_v4i16((LAS s16x4*)(vb + ks * 1024)));
    hh0[ks] = __builtin_bit_cast(s16x4, __builtin_amdgcn_ds_read_tr16_b64_v4i16((LAS s16x4*)(vb + ks * 1024 + 512)));
    lo1[ks] = __builtin_bit_cast(s16x4, __builtin_amdgcn_ds_read_tr16_b64_v4i16((LAS s16x4*)(vb + 4096 + ks * 1024)));
    hh1[ks] = __builtin_bit_cast(s16x4, __builtin_amdgcn_ds_read_tr16_b64_v4i16((LAS s16x4*)(vb + 4096 + ks * 1024 + 512)));
  }
  asm volatile("s_waitcnt lgkmcnt(0)" ::: "memory");
#pragma unroll
  for (int ks = 0; ks < 4; ++ks) {
    const bf16x8 v0 = {lo0[ks][0], lo0[ks][1], lo0[ks][2], lo0[ks][3], hh0[ks][0], hh0[ks][1], hh0[ks][2], hh0[ks][3]};
    const bf16x8 v1 = {lo1[ks][0], lo1[ks][1], lo1[ks][2], lo1[ks][3], hh1[ks][0], hh1[ks][1], hh1[ks][2], hh1[ks][3]};
    S.o0 = __builtin_amdgcn_mfma_f32_32x32x16_bf16(P.pa[ks], v0, S.o0, 0, 0, 0);
    S.o1 = __builtin_amdgcn_mfma_f32_32x32x16_bf16(P.pa[ks], v1, S.o1, 0, 0, 0);
  }
}

__device__ __forceinline__ void attn_unit(LAS unsigned char* lds, const bf16_t* __restrict__ proj, bf16_t* __restrict__ Y, const float* __restrict__ stats, float fbias,
                                          int b, int h, int qb, int tid, bool do_scan) {
  const int lane = tid & 63, wid = __builtin_amdgcn_readfirstlane(tid >> 6), r32 = lane & 31, hi = lane >> 5;
  const int q0 = qb * 256; const size_t rowbase = (size_t)b * SEQ;
  LAS float* cum = (LAS float*)(lds + AT_CUM);
  LAS float* wsf = (LAS float*)(lds + AT_WSF) + wid * 64;
  LAS float* scan = (LAS float*)(lds + AT_SCAN);
  const int NT = (q0 + 256) / 64;
  const int qrow = q0 + wid * 32 + r32;
  const bf16_t* Qw = proj + (rowbase + qrow) * NP + PC_Q + h * 64;
  bf16x8 qr[4];
#pragma unroll
  for (int d0 = 0; d0 < 4; ++d0) qr[d0] = *(const bf16x8*)(Qw + d0 * 16 + hi * 8);
  if (do_scan) {
    const int i0 = tid * 8; float lf[8]; float run = 0.f;
#pragma unroll
    for (int e = 0; e < 8; ++e) {
      float v = 0.f;
      if (i0 + e < q0 + 256) { const float* st = stats + (rowbase + i0 + e) * SROW; const float rs = row_rstd(st); const float z = rs * ((st[1 + h] + st[9 + h]) + (st[17 + h] + st[25 + h])) + fbias;
        v = fminf(z, 0.f) - 0.6931471805599453f * __builtin_amdgcn_logf(1.0f + __builtin_amdgcn_exp2f(-LOG2E * fabsf(z))); }
      run += v; lf[e] = run;
    }
    float incl = run;
#pragma unroll
    for (int o = 1; o < 64; o <<= 1) { const float n = __shfl_up(incl, o); if (lane >= o) incl += n; }
    if (lane == 63) scan[wid] = incl;
    __syncthreads();
    float woff = 0.f;
#pragma unroll
    for (int w = 0; w < 8; ++w) if (w < wid) woff += scan[w];
    const float excl = woff + incl - run;
    f32x4 c0 = {(excl + lf[0]) * LOG2E, (excl + lf[1]) * LOG2E, (excl + lf[2]) * LOG2E, (excl + lf[3]) * LOG2E};
    f32x4 c1 = {(excl + lf[4]) * LOG2E, (excl + lf[5]) * LOG2E, (excl + lf[6]) * LOG2E, (excl + lf[7]) * LOG2E};
    *(LAS f32x4*)(cum + i0) = c0; *(LAS f32x4*)(cum + i0 + 4) = c1;
  }
  __syncthreads();
  const float cref = cum[q0];
  int t0;
  { const bool ok = (lane < NT) ? (cum[64 * lane + 63] - cref <= SKIP_THR) : false; const unsigned long long mk = __ballot(ok); t0 = __builtin_amdgcn_readfirstlane((int)__builtin_ctzll(mk)); }
  const bf16_t* Kh = proj + rowbase * NP + PC_K + h * 64; const bf16_t* Vh = proj + rowbase * NP + PC_VV + h * 64;
  const bf16_t* ksrc = Kh + (size_t)lane * NP + wid * 8;
  const bf16_t* vsrc = Vh + (size_t)((tid >> 2) & 63) * NP + (tid >> 8) * 32 + (tid & 3) * 8;
  u32x4 kA = *(const u32x4*)(ksrc + (size_t)t0 * 64 * NP), vA = *(const u32x4*)(vsrc + (size_t)t0 * 64 * NP), kB = kA, vB = vA;
  if (t0 + 1 < NT) { kB = *(const u32x4*)(ksrc + (size_t)(t0 + 1) * 64 * NP); vB = *(const u32x4*)(vsrc + (size_t)(t0 + 1) * 64 * NP); }
  *(LAS u32x4*)(lds + AT_K + tid * 16) = kA; *(LAS u32x4*)(lds + AT_V + tid * 16) = vA;
  __syncthreads();
  AttnState S; S.mhat = 0.f; S.lsum = 0.f;
#pragma unroll
  for (int r = 0; r < 16; ++r) { S.o0[r] = 0.f; S.o1[r] = 0.f; }
  S.qx = split3(0.f, false, hi == 0);
  const int q0w = q0 + wid * 32, qmax_w = q0w + 31;
  const bool late = wid >= 4;
  AttnP Pc; Pc.resc = false; bool pend = false; int vprev = 0;
#pragma unroll
  for (int k = 0; k < 4; ++k) Pc.pa[k] = (bf16x8){0, 0, 0, 0, 0, 0, 0, 0};
  int vs = 0;
#pragma unroll 1
  for (int t = t0; t < NT; t += 2) {
    if (t + 2 < NT) { kA = *(const u32x4*)(ksrc + (size_t)(t + 2) * 64 * NP); vA = *(const u32x4*)(vsrc + (size_t)(t + 2) * 64 * NP); }
    if (late && pend) { attn_back(S, Pc, lds + AT_V + vprev * 8192, wsf, lane, hi); pend = false; }
    if (64 * t <= qmax_w) {
      attn_front(S, Pc, lds + AT_K, cum, wsf, qr, cref, t, q0w, qrow, r32, hi);
      if (!late) attn_back(S, Pc, lds + AT_V + vs * 8192, wsf, lane, hi); else { pend = true; vprev = vs; }
    }
    { const int vn = (vs == 2) ? 0 : vs + 1;
      if (t + 1 < NT) { *(LAS u32x4*)(lds + AT_K + 8192 + tid * 16) = kB; *(LAS u32x4*)(lds + AT_V + vn * 8192 + tid * 16) = vB; }
      vs = vn; }
    __syncthreads();
    if (t + 1 >= NT) break;
    if (t + 3 < NT) { kB = *(const u32x4*)(ksrc + (size_t)(t + 3) * 64 * NP); vB = *(const u32x4*)(vsrc + (size_t)(t + 3) * 64 * NP); }
    if (late && pend) { attn_back(S, Pc, lds + AT_V + vprev * 8192, wsf, lane, hi); pend = false; }
    if (64 * (t + 1) <= qmax_w) {
      attn_front(S, Pc, lds + AT_K + 8192, cum, wsf, qr, cref, t + 1, q0w, qrow, r32, hi);
      if (!late) attn_back(S, Pc, lds + AT_V + vs * 8192, wsf, lane, hi); else { pend = true; vprev = vs; }
    }
    { const int vn = (vs == 2) ? 0 : vs + 1;
      if (t + 2 < NT) { *(LAS u32x4*)(lds + AT_K + tid * 16) = kA; *(LAS u32x4*)(lds + AT_V + vn * 8192 + tid * 16) = vA; }
      vs = vn; }
    __syncthreads();
  }
  if (late && pend) attn_back(S, Pc, lds + AT_V + vprev * 8192, wsf, lane, hi);
  float lsum = S.lsum; lsum += __shfl_xor(lsum, 32);
  if (hi == 0) wsf[r32] = __builtin_amdgcn_rcpf(lsum);
  LAS float* stg = (LAS float*)(lds + AT_OST) + wid * 2048;
#pragma unroll
  for (int g = 0; g < 4; ++g) { const f32x4 ff = *(const LAS f32x4*)(wsf + 8 * g + 4 * hi);
#pragma unroll
    for (int j = 0; j < 4; ++j) { const int q = 8 * g + 4 * hi + j; stg[q * 64 + r32] = S.o0[4 * g + j] * ff[j]; stg[q * 64 + 32 + r32] = S.o1[4 * g + j] * ff[j]; } }
#pragma unroll
  for (int i = 0; i < 4; ++i) {
    const int row = i * 8 + (lane >> 3), ch = lane & 7;
    const f32x4 a = *(const LAS f32x4*)(stg + row * 64 + ch * 8), c = *(const LAS f32x4*)(stg + row * 64 + ch * 8 + 4);
    const size_t grow = rowbase + q0 + wid * 32 + row;
    float gt[8]; unpack8(*(const u32x4*)(proj + grow * NP + PC_BG + h * 64 + ch * 8), gt);
    u32x4 w; w.x = pk_bf16(a[0] * gt[0], a[1] * gt[1]); w.y = pk_bf16(a[2] * gt[2], a[3] * gt[3]); w.z = pk_bf16(c[0] * gt[4], c[1] * gt[5]); w.w = pk_bf16(c[2] * gt[6], c[3] * gt[7]);
    *(u32x4*)(Y + grow * D + 256 + h * 64 + ch * 8) = w;
  }
  __syncthreads();
}

#define XB_TMO      128
#define XB_XCNT(j)  (256  + 64 * (j))
#define XB_XSUB(j)  (1280 + 64 * (j))
#define XB_XGEN(j)  (2304 + 64 * (j))
#define XB_TOP      3328
#define XB_TOPGEN   3392
#define XCD_BAR_WORDS 3456
#define XB_SPIN_CAP (1u << 18)
__device__ __forceinline__ unsigned xb_ld(unsigned* p)              { return __hip_atomic_load(p, __ATOMIC_RELAXED, __HIP_MEMORY_SCOPE_AGENT); }
__device__ __forceinline__ unsigned xb_add(unsigned* p, unsigned v) { return __hip_atomic_fetch_add(p, v, __ATOMIC_RELAXED, __HIP_MEMORY_SCOPE_AGENT); }
__device__ __forceinline__ unsigned xb_xcc_id() { return (unsigned)__builtin_amdgcn_s_getreg((3 << 11) | 20) & 0xFu; }
#define XB_SPIN(cond, bar) do { unsigned _sp = 0; while (cond) { __builtin_amdgcn_s_sleep(1); \
    if ((++_sp & 255u) == 0u) { if (xb_ld(&(bar)[XB_TMO])) break; if (_sp > XB_SPIN_CAP) { atomicAdd(&(bar)[XB_TMO], 1u); break; } } } } while (0)
struct XcdBarrier { unsigned* bar; unsigned x; volatile LAS unsigned* st; };
__device__ __forceinline__ XcdBarrier xcd_barrier_post(unsigned* bar, volatile LAS unsigned* st) {
  XcdBarrier b; b.bar = bar; b.x = xb_xcc_id(); b.st = st;
  if (threadIdx.x == 0) (void)xb_add(&bar[XB_XCNT(b.x)], 1u);
  return b;
}
__device__ __forceinline__ void xcd_barrier_complete(unsigned* bar, unsigned x, unsigned& nloc, unsigned& nx) {
  const unsigned G = gridDim.x * gridDim.y * gridDim.z;
  unsigned sum, cnt, mine, sp = 0u;
  for (;;) {
    sum = 0u; cnt = 0u; mine = 0u;
#pragma unroll
    for (unsigned j = 0; j < 16; ++j) { const unsigned c = xb_ld(&bar[XB_XCNT(j)]); sum += c; cnt += (c > 0u) ? 1u : 0u; mine = (j == x) ? c : mine; }
    if (sum == G) break;
    __builtin_amdgcn_s_sleep(1);
    if ((++sp & 255u) == 0u) { if (xb_ld(&bar[XB_TMO])) break; if (sp > XB_SPIN_CAP) { atomicAdd(&bar[XB_TMO], 1u); break; } }
  }
  nloc = mine > 0u ? mine : 1u; nx = cnt > 0u ? cnt : 1u;
}
__device__ __forceinline__ void xcd_barrier(const XcdBarrier& b_) {
  asm volatile("s_waitcnt vmcnt(0)" ::: "memory");
  __syncthreads();
  if (threadIdx.x == 0) {
    XcdBarrier b; b.bar = b_.bar; b.st = b_.st; b.x = (unsigned)__builtin_amdgcn_readfirstlane((int)xb_xcc_id());
    unsigned* bar = b.bar;
    __builtin_amdgcn_s_waitcnt(0);
    unsigned nloc = b.st[0], nx = b.st[1];
    if (nloc == 0u) { xcd_barrier_complete(bar, b.x, nloc, nx); b.st[0] = nloc; b.st[1] = nx; }
    const unsigned old = xb_add(&bar[XB_XSUB(b.x)], 1u);
    const unsigned gen = old / nloc;
    if (old + 1u == (gen + 1u) * nloc) {
      __builtin_amdgcn_fence(__ATOMIC_RELEASE, "agent");
      asm volatile("s_waitcnt vmcnt(0)" ::: "memory");
      const unsigned og = xb_add(&bar[XB_TOP], 1u);
      const unsigned tg = og / nx;
      if (og + 1u == (tg + 1u) * nx) xb_add(&bar[XB_TOPGEN], 1u);
      else XB_SPIN(xb_ld(&bar[XB_TOPGEN]) == tg, bar);
      __builtin_amdgcn_fence(__ATOMIC_ACQUIRE, "agent");
      xb_add(&bar[XB_XGEN(b.x)], 1u);
      asm volatile("s_waitcnt vmcnt(0)" ::: "memory");
    } else {
      XB_SPIN(xb_ld(&bar[XB_XGEN(b.x)]) == gen, bar);
      __builtin_amdgcn_fence(__ATOMIC_ACQUIRE, "agent");
      asm volatile("s_waitcnt vmcnt(0)" ::: "memory");
    }
  }
  __syncthreads();
}

__global__ void __launch_bounds__(512, 2) fwd(Params p) {
  extern __shared__ __attribute__((aligned(16))) unsigned char lds_raw[];
  cg::grid_group grid = cg::this_grid();
  LAS unsigned char* lds = (LAS unsigned char*)lds_raw;
  const int tid = threadIdx.x, lane = tid & 63, wid = __builtin_amdgcn_readfirstlane(tid >> 6);
  const int G = gridDim.x, bx = blockIdx.x;
  if (tid < 16) ((LAS unsigned*)(lds + MISC_OFF))[tid] = 0u;
  __syncthreads();
  (void)xcd_barrier_post((unsigned*)(p.ws + WS_CTL), (volatile LAS unsigned*)(lds + MISC_OFF) + 8);
#define PHASE_PTRS() size_t wso_ = 0; asm volatile("" : "+s"(wso_)); unsigned char* ws = p.ws + wso_;     \
  float* stats = (float*)(ws + WS_STATS); bf16_t* xb = (bf16_t*)(ws + WS_XB); bf16_t* proj = (bf16_t*)(ws + WS_R); \
  bf16_t* Pbuf = (bf16_t*)(ws + WS_R); bf16_t* Yb = (bf16_t*)(ws + WS_Y); bf16_t* mrg = (bf16_t*)(ws + WS_MRG); const float* st_l = stats + (size_t)l * M * SROW; \
  (void)stats; (void)xb; (void)proj; (void)Pbuf; (void)Yb; (void)mrg; (void)st_l

#ifndef PH_MASK
#define PH_MASK 0xFF
#endif
#ifndef DUP_PHASE
#define DUP_PHASE 0
#endif
#define GSYNC() do { XcdBarrier xb_; xb_.bar = (unsigned*)(p.ws + WS_CTL); xb_.x = 0; xb_.st = (volatile LAS unsigned*)(lds + MISC_OFF) + 8; xcd_barrier(xb_); if (DUP_PHASE == 5) xcd_barrier(xb_); } while (0)
#define REP(k) _Pragma("unroll 1") for (int rep_ = 0; rep_ < ((DUP_PHASE == (k)) ? 2 : 1); ++rep_)
  REP(1) if constexpr (PH_MASK & 1) p0_prologue(p, lds, tid, lane, wid, G, bx);
  if (p.ws == nullptr) grid.sync();
  GSYNC();

  for (int l = 0; l < 2; ++l) {
    REP(2) if constexpr (PH_MASK & 2) {
      PHASE_PTRS();
      pg8::Gemm g{xb, (const bf16_t*)(ws + WS_W1T) + (size_t)l * NP * D, D, D, D};
      pg8::SchedGrid S; S.init(M, NP, G, bx, D, D);
      pg8::Epi1 E{proj, pg8::RstdLds{st_l, lds}};
      pg8::gemm_phase<pg8::Epi1, pg8::SchedGrid, true>(lds, g, S, E);
    }
    GSYNC();
    REP(3) {
      for (int v = bx; v < 256; v += G) {
        PHASE_PTRS();
        const int bh = (v & 7) * 4 + (v >> 6), s = (v >> 3) & 7; const int b = bh >> 2, h = bh & 3; const float fb = p.f_bias[l * 4 + h];
        if constexpr (PH_MASK & 32) { attn_unit(lds, proj, Yb, st_l, fb, b, h, 15 - s, opaque_v(tid), true);
        attn_unit(lds, proj, Yb, st_l, fb, b, h, s, opaque_v(tid), false); }
      }
      {
        unsigned* qctr = (unsigned*)(p.ws + WS_CTL + 14336) + (l * 2 + rep_) * 16;
        volatile LAS unsigned* qw = (volatile LAS unsigned*)(lds + MISC_OFF) + 12;
#pragma unroll 1
        for (;;) {
          if (tid == 0) qw[0] = __hip_atomic_fetch_add(qctr, 1u, __ATOMIC_RELAXED, __HIP_MEMORY_SCOPE_AGENT);
          __syncthreads();
          const int item = (int)qw[0];
          __syncthreads();
          constexpr int WQ = (I_L + 7) / 8;
          if (item >= 768 + (l == 0 ? WQ : 0)) break;
          if (item >= 768) { const int r = (item - 768) * 8 + wid; if (r < I_L) weight_item(p, 1, r, (LAS float*)(lds + wid * 16384), opaque_v(tid) & 63); __syncthreads(); continue; }
          PHASE_PTRS();
          const int m0 = (item / 3) * 128, kind = item % 3;
          int z = 0; asm volatile("" : "+s"(z));
          if (kind < 2) {
            if constexpr (PH_MASK & 4) conv_c(proj, Yb, p.short_conv_w + l * 3 * 256 + z, m0, opaque_v(tid), 4 * kind);
            asm volatile("" : "+s"(z));
            if constexpr (PH_MASK & 8) conv_d(lds, proj, Yb, p.conf_dw_w + l * 31 * 256 + z, p.conf_dw_b + l * 256 + z, p.conf_ln_g + l * 256 + z, p.conf_ln_b + l * 256 + z, m0, opaque_v(tid), 2 * kind);
          } else {
            if constexpr (PH_MASK & 16) gmlp_unit(lds, proj, Yb, (const bf16_t*)(ws + WS_SGUW) + (size_t)l * 4 * 128 * 128 + z, p.sgu_b + l * 4 * 128 + z, p.sgu_ln_g + l * 256 + z, p.sgu_ln_b + l * 256 + z, m0, opaque_v(tid));
          }
          asm volatile("" : "+s"(z));
          __syncthreads();
        }
      }
    }
    GSYNC();
    REP(4) if constexpr (PH_MASK & 64) for (int vc = bx; vc < 256; vc += G) {
      PHASE_PTRS();
      REP(7) {
        pg8::Gemm g{Yb, (const bf16_t*)(ws + WS_WBT) + (size_t)l * 4 * D * 256, D, 256, 256};
        pg8::SchedPB S{vc}; pg8::Epi3a E{Pbuf};
#ifndef NO3A
        pg8::gemm_phase<pg8::Epi3a, pg8::SchedPB, true>(lds, g, S, E);
#endif
      }
      __builtin_amdgcn_fence(__ATOMIC_RELEASE, "workgroup"); __syncthreads(); __builtin_amdgcn_fence(__ATOMIC_ACQUIRE, "workgroup");
      {
        pg8::Gemm g{xb, (const bf16_t*)(ws + WS_WMT) + (size_t)l * 4096 * D, D, D, D};
        pg8::SchedL S{vc}; pg8::Epi3b E{Pbuf, mrg, pg8::RstdLds{st_l, lds}};
#ifndef NO3B
        pg8::gemm_phase<pg8::Epi3b, pg8::SchedL, true>(lds, g, S, E);
#endif
      }
    }
    GSYNC();
    if constexpr (PH_MASK & 128) {
      PHASE_PTRS();
      pg8::Gemm g{mrg, (const bf16_t*)(ws + WS_WOT) + (size_t)l * D * D, D, D, D};
      pg8::SchedGrid S; S.init(M, D, G, bx, D, D);
      float* st_n = stats + (size_t)(l + 1) * M * SROW;
      if (l == 0) { pg8::Epi4<true> E{p.x, nullptr, xb, st_n, (const float*)(ws + WS_WF) + D * 4, lds}; pg8::gemm_phase<pg8::Epi4<true>, pg8::SchedGrid, true>(lds, g, S, E); }
      else        { pg8::Epi4<false> E{nullptr, xb, Yb, st_n, nullptr, lds}; pg8::gemm_phase<pg8::Epi4<false>, pg8::SchedGrid, true>(lds, g, S, E); }
    }
    GSYNC();
  }
  {
    const int l = 2; PHASE_PTRS();
    const int lane = opaque_v(tid) & 63;
    const float* st = st_l;
    f32x4 gv[4];
#pragma unroll
    for (int j = 0; j < 4; ++j) gv[j] = *((const f32x4*)p.final_g + 64 * j + lane);
    for (int m = bx * 8 + wid; m < M; m += G * 8) {
      const float rs = row_rstd(st + (size_t)m * SROW);
      f32x4* xr = (f32x4*)(p.out + (size_t)m * D) + lane; const u32x2* xs = (const u32x2*)(Yb + (size_t)m * D) + lane;
#pragma unroll
      for (int j = 0; j < 4; ++j) { const u32x2 w = __builtin_nontemporal_load(&xs[64 * j]); const f32x4 v = {bf_lo(w.x), bf_hi(w.x), bf_lo(w.y), bf_hi(w.y)}; __builtin_nontemporal_store(v * rs * gv[j], &xr[64 * j]); }
    }
  }
}

extern "C" void kernel_launch(void* const* d_in, const int* in_sizes, int n_in, void* d_out, int out_size, void* d_ws, size_t ws_size, hipStream_t stream) {
  static int grid_blocks = 0;
  if (!grid_blocks) {
    int dev = 0, cus = 0, per_cu = 0;
    (void)hipGetDevice(&dev);
    (void)hipDeviceGetAttribute(&cus, hipDeviceAttributeMultiprocessorCount, dev);
    (void)hipFuncSetAttribute((const void*)fwd, hipFuncAttributeMaxDynamicSharedMemorySize, LDS_BYTES);
    (void)hipOccupancyMaxActiveBlocksPerMultiprocessor(&per_cu, (const void*)fwd, 512, LDS_BYTES);
    if (per_cu < 1) per_cu = 1;
    grid_blocks = cus * per_cu;
    if (grid_blocks > 256) grid_blocks = 256;
    if (ws_size < WS_END || n_in != 16 || out_size != M * D) fprintf(stderr, "kernel_launch: unexpected sizes: ws %zu (need %zu), n_in %d, out %d\n", ws_size, (size_t)WS_END, n_in, out_size);
  }
  (void)hipMemsetAsync((char*)d_ws + WS_CTL, 0, CTL_BYTES, stream);
  Params p{};
  p.x = (const float*)d_in[0]; p.norm_g = (const float*)d_in[1]; p.w_in = (const float*)d_in[2]; p.f_bias = (const float*)d_in[3]; p.sgu_w = (const float*)d_in[4];
  p.sgu_b = (const float*)d_in[5]; p.sgu_ln_g = (const float*)d_in[6]; p.sgu_ln_b = (const float*)d_in[7]; p.short_conv_w = (const float*)d_in[8]; p.conf_dw_w = (const float*)d_in[9];
  p.conf_dw_b = (const float*)d_in[10]; p.conf_ln_g = (const float*)d_in[11]; p.conf_ln_b = (const float*)d_in[12]; p.w_branch = (const float*)d_in[13]; p.w_out = (const float*)d_in[14];
  p.final_g = (const float*)d_in[15]; p.out = (float*)d_out; p.ws = (unsigned char*)d_ws;
  void* args[] = {&p};
  hipError_t e = hipLaunchCooperativeKernel((void*)fwd, dim3(grid_blocks), dim3(512), args, LDS_BYTES, stream);
  if (e != hipSuccess) fprintf(stderr, "cooperative launch failed: %s (grid %d)\n", hipGetErrorString(e), grid_blocks);
}
```
